# Optimizing an MI355X kernel written in HIP

```python
import math
import jax, jax.numpy as jnp
from jax import lax
import numpy as np

D_MODEL = 2048
BATCH = 2
SEQ = 8192
DEPTH = 1

EPS = 1e-6
HALF_STEP = 0.5
MIX_WIDTH = D_MODEL
A_WIDTH = MIX_WIDTH // 2
A_HEAD_DIM = 128
A_HEADS = A_WIDTH // A_HEAD_DIM
A_CHUNK = 128
B_WIDTH = MIX_WIDTH - A_WIDTH
B_HEAD_DIM = 64
B_HEADS = B_WIDTH // B_HEAD_DIM
B_GROUPS = 2
B_STATE = 128
B_CONV = 4
B_CHUNK = 256
B_CONV_DIM = B_WIDTH + 2 * B_GROUPS * B_STATE
DT_MIN = 0.001
DT_MAX = 0.1
IN_PROJ_DIM = 2 * A_WIDTH + B_WIDTH + B_CONV_DIM + B_HEADS
D_FF = 5504

kernel_name = 'hybrid_gmlp_ssd_macaron_block'


def rmsnorm(x, g):
    xf = x.astype(jnp.float32)
    y = xf * lax.rsqrt(jnp.mean(xf * xf, axis=-1, keepdims=True) + EPS)
    return (y * g.astype(jnp.float32)).astype(x.dtype)


def swiglu(h, w_gate, w_up, w_down):
    return (jax.nn.silu(h @ w_gate) * (h @ w_up)) @ w_down


def causal_depthwise_conv(x, w, b):
    c = x.shape[-1]
    y = lax.conv_general_dilated(x, w.astype(x.dtype)[:, None, :], window_strides=(1,), padding=[(B_CONV - 1, 0)],
                                 dimension_numbers=('NWC', 'WIO', 'NWC'), feature_group_count=c)
    return y + b


def chunked_spatial_gating(u, v, w_s, b_s):
    bsz, seq, _ = u.shape
    nc = seq // A_CHUNK
    mask = jnp.tril(jnp.ones((A_CHUNK, A_CHUNK), dtype=bool))
    w = jnp.where(mask, w_s, 0)
    vc = v.reshape(bsz, nc, A_CHUNK, A_HEADS, A_HEAD_DIM)
    mixed = jnp.einsum('hts,bcshd->bcthd', w, vc) + b_s.T[None, None, :, :, None]
    return u * mixed.reshape(bsz, seq, A_WIDTH)


def segsum_exp(a_cs):
    n = a_cs.shape[-1]
    mask = jnp.tril(jnp.ones((n, n), dtype=bool))
    diff = a_cs[..., :, None] - a_cs[..., None, :]
    return jnp.exp(jnp.where(mask, diff, -jnp.inf))


def pad_seq(t, pad):
    return jnp.pad(t, [(0, 0), (0, pad)] + [(0, 0)] * (t.ndim - 2))


def ssd_chunked(xh, dt, a, bm, cm):
    bsz, seq = xh.shape[:2]
    pad = (-seq) % B_CHUNK
    xh, dt, bm, cm = pad_seq(xh, pad), pad_seq(dt, pad), pad_seq(bm, pad), pad_seq(cm, pad)
    nc = (seq + pad) // B_CHUNK
    r = B_HEADS // B_GROUPS
    x = (xh * dt[..., None]).reshape(bsz, nc, B_CHUNK, B_GROUPS, r, B_HEAD_DIM)
    da = jnp.moveaxis((dt * a).reshape(bsz, nc, B_CHUNK, B_GROUPS, r), 2, -1)
    a_cs = jnp.cumsum(da, axis=-1)
    bc = bm.reshape(bsz, nc, B_CHUNK, B_GROUPS, B_STATE)
    cc = cm.reshape(bsz, nc, B_CHUNK, B_GROUPS, B_STATE)
    decay_in = segsum_exp(a_cs)
    cb = jnp.einsum('bclgn,bcsgn->bcgls', cc, bc)
    y_diag = jnp.einsum('bcgls,bcgrls,bcsgrp->bclgrp', cb, decay_in, x)
    decay_to_end = jnp.exp(a_cs[..., -1:] - a_cs)
    states = jnp.einsum('bclgn,bcgrl,bclgrp->bcgrpn', bc, decay_to_end, x)
    chunk_decay = jnp.exp(a_cs[..., -1])

    def step(carry, inp):
        st, dec = inp
        return carry * dec[..., None, None] + st, carry

    init = jnp.zeros_like(states[:, 0])
    _, prev = lax.scan(step, init, (jnp.moveaxis(states, 1, 0), jnp.moveaxis(chunk_decay, 1, 0)))
    prev = jnp.moveaxis(prev, 0, 1)
    y_off = jnp.einsum('bclgn,bcgrpn,bcgrl->bclgrp', cc, prev, jnp.exp(a_cs))
    y = (y_diag + y_off).reshape(bsz, nc * B_CHUNK, B_HEADS, B_HEAD_DIM)
    return y[:, :seq]


def mamba2_mixer(z, xbc, dt_raw, conv_w, conv_b, dt_bias, a_log, d_skip, ssm_norm):
    bsz, seq, _ = z.shape
    f32 = jnp.float32
    xbc = jax.nn.silu(causal_depthwise_conv(xbc, conv_w, conv_b))
    xs, bm, cm = jnp.split(xbc, [B_WIDTH, B_WIDTH + B_GROUPS * B_STATE], axis=-1)
    dt = jax.nn.softplus(dt_raw.astype(f32) + dt_bias.astype(f32))
    a = -jnp.exp(a_log.astype(f32))
    xh = xs.astype(f32).reshape(bsz, seq, B_HEADS, B_HEAD_DIM)
    y = ssd_chunked(xh, dt, a,
                    bm.astype(f32).reshape(bsz, seq, B_GROUPS, B_STATE),
                    cm.astype(f32).reshape(bsz, seq, B_GROUPS, B_STATE))
    y = y + d_skip.astype(f32)[:, None] * xh
    y = y.reshape(bsz, seq, B_WIDTH) * jax.nn.silu(z.astype(f32))
    yg = y.reshape(bsz, seq, B_GROUPS, B_WIDTH // B_GROUPS)
    yg = yg * lax.rsqrt(jnp.mean(yg * yg, axis=-1, keepdims=True) + EPS)
    return (yg.reshape(bsz, seq, B_WIDTH) * ssm_norm.astype(f32)).astype(z.dtype)


def hybrid_mixer(h, w_in, sgu_norm, w_spatial, b_spatial, conv_w, conv_b, dt_bias, a_log, d_skip, ssm_norm, w_out):
    proj = h @ w_in
    u, v, z, xbc, dt_raw = jnp.split(
        proj, [A_WIDTH, 2 * A_WIDTH, 2 * A_WIDTH + B_WIDTH, 2 * A_WIDTH + B_WIDTH + B_CONV_DIM], axis=-1)
    u = jax.nn.gelu(u, approximate=False)
    v = rmsnorm(jax.nn.gelu(v, approximate=False), sgu_norm)
    y_a = chunked_spatial_gating(u, v, w_spatial, b_spatial)
    y_b = mamba2_mixer(z, xbc, dt_raw, conv_w, conv_b, dt_bias, a_log, d_skip, ssm_norm)
    return jnp.concatenate([y_a, y_b.astype(y_a.dtype)], axis=-1) @ w_out


def setup_inputs(seed: int = 0) -> dict:
    key = jax.random.key(seed)
    ks = jax.random.split(key, 24)
    f32 = jnp.float32
    L = DEPTH

    def nrm(k, shape, scale):
        return jax.random.normal(k, shape, f32) * scale

    def gain(k, shape):
        return 1.0 + 0.05 * jax.random.normal(k, shape, f32)

    x = nrm(ks[0], (BATCH, SEQ, D_MODEL), 1.0)
    ffn1_norm_pre = gain(ks[1], (L, D_MODEL))
    ffn1_norm_post = gain(ks[2], (L, D_MODEL))
    ffn1_w_gate = nrm(ks[3], (L, D_MODEL, D_FF), D_MODEL ** -0.5)
    ffn1_w_up = nrm(ks[4], (L, D_MODEL, D_FF), D_MODEL ** -0.5)
    ffn1_w_down = nrm(ks[5], (L, D_FF, D_MODEL), D_FF ** -0.5)
    mix_norm_pre = gain(ks[6], (L, D_MODEL))
    mix_norm_post = gain(ks[7], (L, D_MODEL))
    w_in = nrm(ks[8], (L, D_MODEL, IN_PROJ_DIM), D_MODEL ** -0.5)
    sgu_norm = gain(ks[9], (L, A_WIDTH))
    w_spatial = nrm(ks[10], (L, A_HEADS, A_CHUNK, A_CHUNK), A_CHUNK ** -0.5)
    b_spatial = 1.0 + 0.1 * jax.random.normal(ks[11], (L, A_HEADS, A_CHUNK), f32)
    conv_w = nrm(ks[12], (L, B_CONV, B_CONV_DIM), B_CONV ** -0.5)
    conv_b = nrm(ks[13], (L, B_CONV_DIM), 0.02)
    dt0 = jnp.exp(jax.random.uniform(ks[14], (L, B_HEADS), f32, math.log(DT_MIN), math.log(DT_MAX)))
    dt_bias = dt0 + jnp.log(-jnp.expm1(-dt0))
    a_log = jnp.log(jax.random.uniform(ks[15], (L, B_HEADS), f32, 1.0, 16.0))
    d_skip = gain(ks[16], (L, B_HEADS))
    ssm_norm = gain(ks[17], (L, B_WIDTH))
    w_out = nrm(ks[18], (L, MIX_WIDTH, D_MODEL), MIX_WIDTH ** -0.5)
    ffn2_norm_pre = gain(ks[19], (L, D_MODEL))
    ffn2_norm_post = gain(ks[20], (L, D_MODEL))
    ffn2_w_gate = nrm(ks[21], (L, D_MODEL, D_FF), D_MODEL ** -0.5)
    ffn2_w_up = nrm(ks[22], (L, D_MODEL, D_FF), D_MODEL ** -0.5)
    ffn2_w_down = nrm(ks[23], (L, D_FF, D_MODEL), D_FF ** -0.5)
    return {'x': x,
            'ffn1_norm_pre': ffn1_norm_pre, 'ffn1_norm_post': ffn1_norm_post,
            'ffn1_w_gate': ffn1_w_gate, 'ffn1_w_up': ffn1_w_up, 'ffn1_w_down': ffn1_w_down,
            'mix_norm_pre': mix_norm_pre, 'mix_norm_post': mix_norm_post, 'w_in': w_in,
            'sgu_norm': sgu_norm, 'w_spatial': w_spatial, 'b_spatial': b_spatial,
            'conv_w': conv_w, 'conv_b': conv_b, 'dt_bias': dt_bias, 'a_log': a_log,
            'd_skip': d_skip, 'ssm_norm': ssm_norm, 'w_out': w_out,
            'ffn2_norm_pre': ffn2_norm_pre, 'ffn2_norm_post': ffn2_norm_post,
            'ffn2_w_gate': ffn2_w_gate, 'ffn2_w_up': ffn2_w_up, 'ffn2_w_down': ffn2_w_down}


def reference(x, ffn1_norm_pre, ffn1_norm_post, ffn1_w_gate, ffn1_w_up, ffn1_w_down,
              mix_norm_pre, mix_norm_post, w_in, sgu_norm, w_spatial, b_spatial,
              conv_w, conv_b, dt_bias, a_log, d_skip, ssm_norm, w_out,
              ffn2_norm_pre, ffn2_norm_post, ffn2_w_gate, ffn2_w_up, ffn2_w_down):
    for l in range(DEPTH):
        h = swiglu(rmsnorm(x, ffn1_norm_pre[l]), ffn1_w_gate[l], ffn1_w_up[l], ffn1_w_down[l])
        x = x + HALF_STEP * rmsnorm(h, ffn1_norm_post[l])
        h = hybrid_mixer(rmsnorm(x, mix_norm_pre[l]), w_in[l], sgu_norm[l], w_spatial[l], b_spatial[l],
                         conv_w[l], conv_b[l], dt_bias[l], a_log[l], d_skip[l], ssm_norm[l], w_out[l])
        x = x + rmsnorm(h, mix_norm_post[l])
        h = swiglu(rmsnorm(x, ffn2_norm_pre[l]), ffn2_w_gate[l], ffn2_w_up[l], ffn2_w_down[l])
        x = x + HALF_STEP * rmsnorm(h, ffn2_norm_post[l])
    return x
```

```cpp
#include <hip/hip_runtime.h>
#include <hip/hip_cooperative_groups.h>
#include <cstdio>
namespace cg = cooperative_groups;
namespace pg8 {
#define PG8_LAS __attribute__((address_space(3)))
typedef unsigned short bf16_t;
typedef short bf16x8 __attribute__((ext_vector_type(8)));
typedef float f32x4 __attribute__((ext_vector_type(4)));
typedef unsigned u32x4 __attribute__((ext_vector_type(4)));
constexpr int BM = 256, BK = 64, HALF = 128, HTB = HALF * BK * 2  , STAGE_BYTES = 8 * HTB, NXCD = 8, WGM = 8;

__host__ __device__ __forceinline__ int lds_byte(int r, int c) { const int st = (r >> 4) * 2 + (c >> 5), rr = r & 15, cc = c & 31, ob = rr * 64 + cc * 2; return st * 1024 + (ob ^ (((ob >> 9) & 1) << 5)); }
__host__ __device__ __forceinline__ void stage_rc(int b, int& R, int& C) { const int st = b / 1024, sb = b % 1024, swz = sb ^ (((sb >> 9) & 1) << 5); R = (st >> 1) * 16 + swz / 64; C = (st & 1) * 32 + (swz % 64) / 2; }
__host__ __device__ __forceinline__ int perm32(int rho) { const int n = rho >> 4, i = rho & 15; return 8 * (i >> 2) + 4 * n + (i & 3); }

struct Unit { int pm, pn; };
struct Gemm { const bf16_t* A; const bf16_t* Bt; int M, N, K; };

struct StaticOrder {
    int nM, nN, nwg, G, c;
    __host__ __device__ void init(int M, int N, int G_, int c_) { nM = M / BM; nN = N / BM; nwg = nM * nN; G = G_; c = c_; }
    __host__ __device__ bool next(int i, Unit& u) const {
        const long L = (long)i * G + c; if (L >= nwg) return false;
        int wgid = (int)L; { const int q = nwg / NXCD, r = nwg % NXCD, xcd = wgid % NXCD, off = wgid / NXCD; wgid = (xcd < r ? xcd * (q + 1) : r * (q + 1) + (xcd - r) * q) + off; }
        const int nig = WGM * nN, gid = wgid / nig, fm = gid * WGM, gsz = (nM - fm) < WGM ? (nM - fm) : WGM;
        u.pm = fm + ((wgid % nig) % gsz); u.pn = (wgid % nig) / gsz; return true;
    }
    __device__ __forceinline__ void a_ready(const Unit&) const {}
    __device__ __forceinline__ void done(const Unit&) const {}
};
struct CountedOrder : StaticOrder {
    const unsigned* ready; unsigned need; unsigned* tmo;
    __device__ __forceinline__ void a_ready(const Unit& u) const {
        if (threadIdx.x < 64) {
            const unsigned long long t0 = __builtin_amdgcn_s_memrealtime(); unsigned polls = 0;
            while ((unsigned)__builtin_amdgcn_readfirstlane(__hip_atomic_load(ready + 64 * u.pm, __ATOMIC_RELAXED, __HIP_MEMORY_SCOPE_AGENT)) < need) {
                if ((++polls & 255u) == 0u && __builtin_amdgcn_readfirstlane(__hip_atomic_load(tmo, __ATOMIC_RELAXED, __HIP_MEMORY_SCOPE_AGENT)) != 0u) break;
                if (__builtin_amdgcn_s_memrealtime() - t0 > 2000000ull) {
                    if (threadIdx.x == 0) { unsigned expect = 0u; __hip_atomic_compare_exchange_strong(tmo + 1, &expect, 0x600u | (unsigned)(u.pm & 0xff), __ATOMIC_RELAXED, __ATOMIC_RELAXED, __HIP_MEMORY_SCOPE_AGENT); __hip_atomic_store(tmo, 1u, __ATOMIC_RELAXED, __HIP_MEMORY_SCOPE_AGENT); }
                    break; }
                __builtin_amdgcn_s_sleep(2); }
            __builtin_amdgcn_fence(__ATOMIC_ACQUIRE, "agent");
            asm volatile("s_waitcnt vmcnt(0)" ::: "memory");
        }
#if !defined(BROKEN_HOOK_NO_BARRIER)
        asm volatile("" ::: "memory"); __builtin_amdgcn_s_barrier(); asm volatile("" ::: "memory");
#endif
    }
};

__device__ __forceinline__ unsigned cvt_pk_bf16(float lo, float hi) { unsigned r; asm volatile("v_cvt_pk_bf16_f32 %0, %1, %2" : "=v"(r) : "v"(lo), "v"(hi)); return r; }
typedef float f32x2 __attribute__((ext_vector_type(2)));
__device__ __forceinline__ f32x2 gelu_pk(f32x2 v) {
    const f32x2 av = __builtin_elementwise_abs(v), d = av * 0.2316418882f + 1.0f;
    f32x2 t; t.x = __builtin_amdgcn_rcpf(d.x); t.y = __builtin_amdgcn_rcpf(d.y);
    f32x2 q = t * 0.5307027145f + (-0.7265760135f); q = q * t + 0.7107068705f; q = q * t + (-0.142248368f); q = q * t + 0.127414796f; q = q * t;
    const f32x2 s = (v * v) * (-0.72134752044f);
    f32x2 e; e.x = __builtin_amdgcn_exp2f(s.x); e.y = __builtin_amdgcn_exp2f(s.y);
    const f32x2 m = v * (q * e), r = v - m;
    f32x2 o; o.x = v.x < 0.f ? m.x : r.x; o.y = v.y < 0.f ? m.y : r.y; return o;
}

struct EpiF32 {
    static constexpr bool PERM = false, AFTER_DRAIN = false;
    float* C; int ldc; const float* bias;
    __device__ __forceinline__ void operator()(const f32x4 (&acc)[2][2][4][2], const Unit& u, int wr, int wc, int fr, int fq) const {
        const int row0 = u.pm * BM + wr * 64 + fr, col0 = u.pn * BM + wc * 32 + 4 * fq;
        f32x4 bv[2][2];
#pragma unroll
        for (int bj = 0; bj < 2; ++bj)
#pragma unroll
            for (int n = 0; n < 2; ++n) bv[bj][n] = bias ? *(const f32x4*)(bias + col0 + bj * HALF + n * 16) : (f32x4){0.f, 0.f, 0.f, 0.f};
#pragma unroll
        for (int ai = 0; ai < 2; ++ai)
#pragma unroll
            for (int m = 0; m < 4; ++m) { float* rowp = C + (size_t)(row0 + ai * HALF + m * 16) * ldc + col0;
#pragma unroll
                for (int bj = 0; bj < 2; ++bj)
#pragma unroll
                    for (int n = 0; n < 2; ++n) *(f32x4*)(rowp + bj * HALF + n * 16) = acc[ai][bj][m][n] + bv[bj][n]; }
    }
};
}
namespace pg8 {
__device__ __forceinline__ float silu_f(float g) { return g * __builtin_amdgcn_rcpf(1.0f + __expf(-g)); }
struct EpiSwiGLU {
    static constexpr bool PERM = true, AFTER_DRAIN = false;
    bf16_t* O; int ldc;
    __device__ __forceinline__ void operator()(const f32x4 (&acc)[2][2][4][2], const Unit& u, int wr, int wc, int fr, int fq) const {
        const int row0 = u.pm * BM + wr * 64 + fr, col0 = u.pn * 128 + wc * 32 + 8 * fq;
#pragma unroll
        for (int ai = 0; ai < 2; ++ai)
#pragma unroll
            for (int m = 0; m < 4; ++m) {
                bf16_t* rowp = O + (size_t)(row0 + ai * HALF + m * 16) * ldc + col0;
                const f32x4 g0 = acc[ai][0][m][0], g1 = acc[ai][0][m][1], u0 = acc[ai][1][m][0], u1 = acc[ai][1][m][1];
                u32x4 w;
                w.x = cvt_pk_bf16(silu_f(g0[0]) * u0[0], silu_f(g0[1]) * u0[1]);
                w.y = cvt_pk_bf16(silu_f(g0[2]) * u0[2], silu_f(g0[3]) * u0[3]);
                w.z = cvt_pk_bf16(silu_f(g1[0]) * u1[0], silu_f(g1[1]) * u1[1]);
                w.w = cvt_pk_bf16(silu_f(g1[2]) * u1[2], silu_f(g1[3]) * u1[3]);
                *(u32x4*)rowp = w;
            }
    }
};
struct EpiInProj {
    static constexpr bool PERM = true, AFTER_DRAIN = false;
    bf16_t *GU, *GV, *Z, *XBC; float* vss;
    __device__ __forceinline__ void operator()(const f32x4 (&acc)[2][2][4][2], const Unit& u, int wr, int wc, int fr, int fq) const {
        const int pn = u.pn; const int row0 = u.pm * BM + wr * 64 + fr;
        bf16_t* base; int ldc, colt, mode;
        if (pn < 4) { base = GU; ldc = 1024; colt = pn * 256; mode = 0; }
        else if (pn < 8) { base = GV; ldc = 1024; colt = (pn - 4) * 256; mode = 1; }
        else if (pn < 12) { base = Z; ldc = 1024; colt = (pn - 8) * 256; mode = 2; }
        else { base = XBC; ldc = 1536; colt = (pn - 12) * 256; mode = 3; }
        const int col0 = colt + wc * 32 + 8 * fq;
#pragma unroll
        for (int ai = 0; ai < 2; ++ai)
#pragma unroll
            for (int m = 0; m < 4; ++m) {
                const int row = row0 + ai * HALF + m * 16;
                bf16_t* rowp = base + (size_t)row * ldc + col0; float ssq = 0.f;
#pragma unroll
                for (int bj = 0; bj < 2; ++bj) {
                    f32x4 v0 = acc[ai][bj][m][0], v1 = acc[ai][bj][m][1];
                    if (mode <= 1) {
                        f32x2 a = gelu_pk((f32x2){v0[0], v0[1]}), b = gelu_pk((f32x2){v0[2], v0[3]}), c = gelu_pk((f32x2){v1[0], v1[1]}), d = gelu_pk((f32x2){v1[2], v1[3]});
                        v0 = (f32x4){a.x, a.y, b.x, b.y}; v1 = (f32x4){c.x, c.y, d.x, d.y};
                        ssq += (v0[0] * v0[0] + v0[1] * v0[1]) + (v0[2] * v0[2] + v0[3] * v0[3]) + (v1[0] * v1[0] + v1[1] * v1[1]) + (v1[2] * v1[2] + v1[3] * v1[3]);
                    } else if (mode == 2) {
#pragma unroll
                        for (int j = 0; j < 4; ++j) { v0[j] = silu_f(v0[j]); v1[j] = silu_f(v1[j]); }
                    }
                    u32x4 w; w.x = cvt_pk_bf16(v0[0], v0[1]); w.y = cvt_pk_bf16(v0[2], v0[3]); w.z = cvt_pk_bf16(v1[0], v1[1]); w.w = cvt_pk_bf16(v1[2], v1[3]);
                    *(u32x4*)(rowp + bj * HALF) = w;
                }
                if (mode == 1) { ssq += __shfl_xor(ssq, 16); ssq += __shfl_xor(ssq, 32); if (fq == 0) unsafeAtomicAdd(vss + row, ssq); }
            }
    }
};
}
namespace pg8 {
template <class Epi, class Sched, bool STAMP = false>
__device__ __forceinline__ void gemm_phase(PG8_LAS unsigned char* lds, const Gemm g, const Sched& S, const Epi& E, unsigned long long* stamps) {
    const int tid = threadIdx.x, wid = __builtin_amdgcn_readfirstlane(tid >> 6), lane = tid & 63, wr = wid >> 2, wc = wid & 3, fr = lane & 15, fq = lane >> 4;
    const int K = g.K, nt = K / BK;
    int ts_lo = 0, ts_hi = 0, nts = 0; const unsigned long long rt_entry = STAMP ? (unsigned long long)wall_clock64() : 0ull;
#define PG8_STAMP() do { if (STAMP && wid == 0 && nts < 64) { const unsigned long long _c = (unsigned long long)clock64(); \
        ts_lo = (lane == nts) ? (int)(unsigned)_c : ts_lo; ts_hi = (lane == nts) ? (int)(unsigned)(_c >> 32) : ts_hi; ++nts; } } while (0)
    PG8_STAMP();
    unsigned voffA[2], voffB[2];
#pragma unroll
    for (int i = 0; i < 2; ++i) { int R, C; stage_rc(tid * 16 + i * 8192, R, C); const int Rb = Epi::PERM ? ((R & ~31) + perm32(R & 31)) : R;
        voffA[i] = (unsigned)(R * K + C) * 2u; voffB[i] = (unsigned)(Rb * K + C) * 2u; }
    const size_t kstep = (size_t)(BK * 2);
    const size_t hstep = (size_t)HALF * K * 2;
    const size_t tstep = 2 * hstep;
    const unsigned ldsw = (unsigned)wid * 1024u;
    const int aoff = lds_byte(wr * 64 + fr, fq * 8), boff = lds_byte(wc * 32 + fr, fq * 8);
#define PG8_SA(b, h) (((b) * 2 + (h)) * HTB)
#define PG8_SB(b, h) ((4 + (b) * 2 + (h)) * HTB)
#define PG8_STAGE(bufoff, gbase, voff) do { _Pragma("unroll") for (int _i = 0; _i < 2; ++_i) \
        __builtin_amdgcn_global_load_lds((const unsigned*)((const char*)(gbase) + (voff)[_i]), (PG8_LAS unsigned*)(lds + (bufoff) + ldsw + _i * 8192), 16, 0, 0); } while (0)
#define PG8_LDA(dst, b, h) do { _Pragma("unroll") for (int m = 0; m < 4; ++m) _Pragma("unroll") for (int k = 0; k < 2; ++k) dst[m][k] = *(const PG8_LAS bf16x8*)(lds + PG8_SA(b, h) + aoff + m * 2048 + k * 1024); } while (0)
#define PG8_LDB(dst, b, h) do { _Pragma("unroll") for (int n = 0; n < 2; ++n) _Pragma("unroll") for (int k = 0; k < 2; ++k) dst[n][k] = *(const PG8_LAS bf16x8*)(lds + PG8_SB(b, h) + boff + n * 2048 + k * 1024); } while (0)
#define PG8_MMA(ai, bj, At, Bt) do { __builtin_amdgcn_s_setprio(1); _Pragma("unroll") for (int m = 0; m < 4; ++m) _Pragma("unroll") for (int n = 0; n < 2; ++n) _Pragma("unroll") for (int k = 0; k < 2; ++k) \
        acc[ai][bj][m][n] = __builtin_amdgcn_mfma_f32_16x16x32_bf16(Bt[n][k], At[m][k], acc[ai][bj][m][n], 0, 0, 0); __builtin_amdgcn_s_setprio(0); } while (0)
#define PG8_WAIT_V(n) asm volatile("s_waitcnt vmcnt(" #n ")" ::: "memory")
#define PG8_WAIT_L(n) asm volatile("s_waitcnt lgkmcnt(" #n ")" ::: "memory")
#define PG8_BAR __builtin_amdgcn_s_barrier()
#define PG8_SCHED __builtin_amdgcn_sched_barrier(0)
    Unit cur, nxt; int ui = 0;
    if (!S.next(0, cur)) return;
    f32x4 acc[2][2][4][2];
#pragma unroll
    for (int a = 0; a < 2; ++a)
#pragma unroll
        for (int b = 0; b < 2; ++b)
#pragma unroll
            for (int m = 0; m < 4; ++m)
#pragma unroll
                for (int n = 0; n < 2; ++n) acc[a][b][m][n] = (f32x4){0.f, 0.f, 0.f, 0.f};
    bf16x8 At[4][2], B0[2][2], B1[2][2];
    const char* cA = (const char*)g.A + (size_t)cur.pm * tstep; const char* cB = (const char*)g.Bt + (size_t)cur.pn * tstep;
    S.a_ready(cur);
    PG8_STAGE(PG8_SB(0, 0), cB, voffB); PG8_STAGE(PG8_SA(0, 0), cA, voffA); PG8_STAGE(PG8_SB(0, 1), cB + hstep, voffB); PG8_STAGE(PG8_SA(0, 1), cA + hstep, voffA);
    if (wr == 1) PG8_BAR;
    PG8_WAIT_V(4); PG8_BAR;
    PG8_STAGE(PG8_SB(1, 0), cB + kstep, voffB); PG8_STAGE(PG8_SA(1, 0), cA + kstep, voffA); PG8_STAGE(PG8_SB(1, 1), cB + hstep + kstep, voffB);
    PG8_WAIT_V(6); PG8_BAR;
    PG8_STAMP();
    for (;;) {
        const bool has_next = S.next(ui + 1, nxt);
        const char* nA = has_next ? (const char*)g.A + (size_t)nxt.pm * tstep : cA; const char* nB = has_next ? (const char*)g.Bt + (size_t)nxt.pn * tstep : cB;
        for (int t = 0; t < nt; t += 2) {
            const bool last = (t == nt - 2);
            const char* a1 = cA + (size_t)(t + 1) * kstep;
            const char* a2 = last ? nA : cA + (size_t)(t + 2) * kstep; const char* b2 = last ? nB : cB + (size_t)(t + 2) * kstep;
            const char* a3 = a2 + kstep; const char* b3 = b2 + kstep;
            if (last && has_next) S.a_ready(nxt);
            PG8_LDB(B0, 0, 0); PG8_SCHED; PG8_LDA(At, 0, 0); PG8_STAGE(PG8_SA(1, 1), a1 + hstep, voffA);
            PG8_WAIT_L(8); PG8_BAR; PG8_WAIT_L(0); PG8_MMA(0, 0, At, B0); PG8_BAR; PG8_SCHED;
            PG8_LDB(B1, 0, 1); PG8_STAGE(PG8_SB(0, 0), b2, voffB);
            PG8_BAR; PG8_WAIT_L(0); PG8_MMA(0, 1, At, B1); PG8_BAR;
            PG8_LDA(At, 0, 1); PG8_STAGE(PG8_SA(0, 0), a2, voffA);
            PG8_BAR; PG8_WAIT_L(0); PG8_MMA(1, 0, At, B0); PG8_BAR; PG8_SCHED;
            PG8_STAGE(PG8_SB(0, 1), b2 + hstep, voffB);
            PG8_WAIT_V(6); PG8_BAR; PG8_MMA(1, 1, At, B1); PG8_BAR;
            PG8_LDB(B0, 1, 0); PG8_SCHED; PG8_LDA(At, 1, 0); PG8_STAGE(PG8_SA(0, 1), a2 + hstep, voffA);
            PG8_WAIT_L(8); PG8_BAR; PG8_WAIT_L(0); PG8_MMA(0, 0, At, B0); PG8_BAR; PG8_SCHED;
            PG8_LDB(B1, 1, 1); PG8_STAGE(PG8_SB(1, 0), b3, voffB);
            PG8_BAR; PG8_WAIT_L(0); PG8_MMA(0, 1, At, B1); PG8_BAR;
            PG8_LDA(At, 1, 1); PG8_STAGE(PG8_SA(1, 0), a3, voffA);
            PG8_BAR; PG8_WAIT_L(0); PG8_MMA(1, 0, At, B0); PG8_BAR; PG8_SCHED;
            PG8_STAGE(PG8_SB(1, 1), b3 + hstep, voffB);
            PG8_WAIT_V(6); PG8_BAR; PG8_MMA(1, 1, At, B1); PG8_BAR;
        }
        PG8_STAMP();
        if constexpr (!Epi::AFTER_DRAIN) { E(acc, cur, wr, wc, fr, fq); S.done(cur); }
        PG8_STAMP();
        if (!has_next) break;
#pragma unroll
        for (int a = 0; a < 2; ++a)
#pragma unroll
            for (int b = 0; b < 2; ++b)
#pragma unroll
                for (int m = 0; m < 4; ++m)
#pragma unroll
                    for (int n = 0; n < 2; ++n) acc[a][b][m][n] = (f32x4){0.f, 0.f, 0.f, 0.f};
        cur = nxt; cA = nA; cB = nB; ++ui;
    }
    PG8_WAIT_V(0);
    if (wr == 0) PG8_BAR;
    PG8_BAR;
    if constexpr (Epi::AFTER_DRAIN) { E.fused(acc, cur, wr, wc, fr, fq, lds, wid, lane); S.done(cur); }
    PG8_STAMP();
    if (STAMP && wid == 0) { stamps[lane] = lane < nts ? (((unsigned long long)(unsigned)ts_hi << 32) | (unsigned)ts_lo) : 0ull;
        if (lane == 62) stamps[62] = rt_entry; if (lane == 63) stamps[63] = (unsigned long long)wall_clock64(); }
#undef PG8_STAMP
#undef PG8_SA
#undef PG8_SB
#undef PG8_STAGE
#undef PG8_LDA
#undef PG8_LDB
#undef PG8_MMA
#undef PG8_WAIT_V
#undef PG8_WAIT_L
#undef PG8_BAR
#undef PG8_SCHED
}
}
#define LAS __attribute__((address_space(3)))
typedef unsigned short bf16;
typedef unsigned v4u __attribute__((ext_vector_type(4)));
typedef unsigned v2u __attribute__((ext_vector_type(2)));
typedef float f32x4 __attribute__((ext_vector_type(4)));
typedef short bf16x8 __attribute__((ext_vector_type(8)));

constexpr int M = 16384, SEQ = 8192, D = 2048, FF = 5504, NGU = 2 * FF, AW = 1024, NIN = 4608, NINF = 4624, XBCW = 1536;
constexpr float EPS = 1e-6f;
constexpr size_t MiB = 1u << 20;
constexpr size_t WS_VSS = 0;
constexpr size_t WS_WGU1 = 1 * MiB, WS_WD1 = 44 * MiB, WS_WGU2 = 66 * MiB, WS_WD2 = 109 * MiB, WS_WIN = 131 * MiB, WS_WOUT = 150 * MiB, WS_WSP = 158 * MiB;
constexpr size_t WS_HB = 159 * MiB;
constexpr size_t WS_GU = 159 * MiB, WS_GV = 191 * MiB, WS_Z = 223 * MiB, WS_XBC = 255 * MiB, WS_DTRAW = 303 * MiB, WS_DT = 304 * MiB, WS_ACS = 305 * MiB, WS_BM = 306 * MiB, WS_CM = 314 * MiB;
constexpr size_t WS_HF2 = 159 * MiB;
constexpr size_t WS_XN = 331 * MiB;
constexpr size_t WS_YCAT = 331 * MiB;
constexpr size_t WS_XS = 395 * MiB, WS_XDTT = 427 * MiB, WS_ST = 459 * MiB, WS_PREV = 491 * MiB, WS_END = 507 * MiB;
constexpr size_t WS_HF3 = 331 * MiB;
static_assert(WS_HB + (size_t)M * FF * 2 <= WS_XN, "HB");
static_assert(WS_CM + 8 * MiB <= WS_XN && WS_HF3 + 128 * MiB <= WS_END, "map");

constexpr int LDS_BYTES = 147456;

__device__ __forceinline__ float bflo(unsigned w) { return __uint_as_float(w << 16); }
__device__ __forceinline__ float bfhi(unsigned w) { return __uint_as_float(w & 0xffff0000u); }
__device__ __forceinline__ unsigned pk2(float lo, float hi) { return pg8::cvt_pk_bf16(lo, hi); }
__device__ __forceinline__ unsigned short f2bf1(float f) { return (unsigned short)(pk2(f, 0.f) & 0xffffu); }
__device__ __forceinline__ float wave_sum(float v) {
#pragma unroll
    for (int o = 1; o < 64; o <<= 1) v += __shfl_xor(v, o);
    return v;
}
__device__ __forceinline__ float silu1(float g) { return g * __builtin_amdgcn_rcpf(1.0f + __expf(-g)); }
#define MFMA16(a, b, c) __builtin_amdgcn_mfma_f32_16x16x32_bf16((a), (b), (c), 0, 0, 0)

__device__ __forceinline__ void transpose_item(const float* W, int ldn, int K, bf16* WT, int k0, int n0, int drow0, LAS float* scr, int lane) {
#pragma unroll 8
    for (int i = 0; i < 32; ++i) { const int kk = 2 * i + (lane >> 5); scr[kk * 33 + (lane & 31)] = W[(size_t)(k0 + kk) * ldn + n0 + (lane & 31)]; }
    asm volatile("s_waitcnt lgkmcnt(0)" ::: "memory");
    const int c = lane & 7;
#pragma unroll
    for (int j = 0; j < 4; ++j) { const int n = (lane >> 3) + 8 * j; const LAS float* s = scr + (8 * c) * 33 + n;
        v4u o; o.x = pk2(s[0 * 33], s[1 * 33]); o.y = pk2(s[2 * 33], s[3 * 33]); o.z = pk2(s[4 * 33], s[5 * 33]); o.w = pk2(s[6 * 33], s[7 * 33]);
        *(v4u*)(WT + (size_t)(drow0 + n) * K + k0 + 8 * c) = o; }
    asm volatile("s_waitcnt lgkmcnt(0)" ::: "memory");
}
__device__ __forceinline__ void transpose_seg(const float* W, int ldn, int K, int nblk, bf16* WT, int mode, int item, LAS float* scr, int lane) {
    const int kb = item / nblk, nb = item % nblk, n0 = 32 * nb;
    const int drow0 = mode == 0 ? n0 : (n0 + 128 * (n0 >> 7) + (mode == 2 ? 128 : 0));
    transpose_item(W, ldn, K, WT, 64 * kb, n0, drow0, scr, lane);
}

template <int MODE>
__device__ __forceinline__ void row_pass(int gw, int NGW, int lane, const float* hsrc, const float* xres, float* xdst, float sc, const float* gpost, const float* gpre, bf16* xn) {
    for (int m = gw; m < M; m += NGW) {
        f32x4 xv[8];
        const f32x4* xr = (const f32x4*)(xres + (size_t)m * D) + lane;
        if (MODE >= 1) {
            f32x4 hv[8]; float ss = 0.f;
            const f32x4* hr = (const f32x4*)(hsrc + (size_t)m * D) + lane;
#pragma unroll
            for (int j = 0; j < 8; ++j) { hv[j] = hr[64 * j]; ss += (hv[j].x * hv[j].x + hv[j].y * hv[j].y) + (hv[j].z * hv[j].z + hv[j].w * hv[j].w); }
            const float rs = sc * __frsqrt_rn(wave_sum(ss) * (1.0f / D) + EPS);
            f32x4* xo = (f32x4*)(xdst + (size_t)m * D) + lane;
#pragma unroll
            for (int j = 0; j < 8; ++j) { const f32x4 g = ((const f32x4*)gpost)[64 * j + lane]; xv[j] = xr[64 * j] + hv[j] * g * rs; xo[64 * j] = xv[j]; }
        } else {
#pragma unroll
            for (int j = 0; j < 8; ++j) xv[j] = xr[64 * j];
        }
        if (MODE != 2) {
            float ss = 0.f;
#pragma unroll
            for (int j = 0; j < 8; ++j) ss += (xv[j].x * xv[j].x + xv[j].y * xv[j].y) + (xv[j].z * xv[j].z + xv[j].w * xv[j].w);
            const float rs = __frsqrt_rn(wave_sum(ss) * (1.0f / D) + EPS);
            v2u* o8 = (v2u*)(xn + (size_t)m * D) + lane;
#pragma unroll
            for (int j = 0; j < 8; ++j) { const f32x4 g = ((const f32x4*)gpre)[64 * j + lane]; v2u w; w.x = pk2(xv[j].x * rs * g.x, xv[j].y * rs * g.y); w.y = pk2(xv[j].z * rs * g.z, xv[j].w * rs * g.w); o8[64 * j] = w; }
        }
    }
}

struct Args { const float* in[24]; float* out; unsigned char* ws; };

__global__ void __launch_bounds__(512, 2) fwd_mega(Args a) {
    extern __shared__ __attribute__((aligned(16))) unsigned char lds_raw[];
    LAS unsigned char* lds = (LAS unsigned char*)lds_raw;
    cg::grid_group grid = cg::this_grid();
#define GRID_SYNC() grid.sync()
    const int tid = threadIdx.x, lane = tid & 63, wave = __builtin_amdgcn_readfirstlane(tid >> 6);
    const int G = gridDim.x, bx = blockIdx.x;
    const int gw = bx * 8 + wave, NGW = G * 8, gt = bx * 512 + tid, NT = G * 512;
    const int fr = lane & 15, fq = lane >> 4;
    unsigned char* ws = a.ws;
    float* const out = a.out;
    float* const VSS = (float*)(ws + WS_VSS);
    bf16* const WGU1 = (bf16*)(ws + WS_WGU1); bf16* const WD1 = (bf16*)(ws + WS_WD1); bf16* const WGU2 = (bf16*)(ws + WS_WGU2); bf16* const WD2 = (bf16*)(ws + WS_WD2);
    bf16* const WIN = (bf16*)(ws + WS_WIN); bf16* const WOUT = (bf16*)(ws + WS_WOUT); bf16* const WSP = (bf16*)(ws + WS_WSP);
    bf16* const HB = (bf16*)(ws + WS_HB); bf16* const XN = (bf16*)(ws + WS_XN); bf16* const YCAT = (bf16*)(ws + WS_YCAT);
    bf16* const GU = (bf16*)(ws + WS_GU); bf16* const GV = (bf16*)(ws + WS_GV); bf16* const ZB = (bf16*)(ws + WS_Z); bf16* const XBC = (bf16*)(ws + WS_XBC);
    float* const DTRAW = (float*)(ws + WS_DTRAW); float* const DT = (float*)(ws + WS_DT); float* const ACS = (float*)(ws + WS_ACS);
    bf16* const BMm = (bf16*)(ws + WS_BM); bf16* const CMm = (bf16*)(ws + WS_CM); bf16* const XS = (bf16*)(ws + WS_XS); bf16* const XDTT = (bf16*)(ws + WS_XDTT);
    float* const ST = (float*)(ws + WS_ST); bf16* const PREV = (bf16*)(ws + WS_PREV);
    float* const HF2 = (float*)(ws + WS_HF2); float* const HF3 = (float*)(ws + WS_HF3);

    {
        LAS float* scr = (LAS float*)(lds + wave * 16384);
        constexpr int I_GU = (D / 64) * (FF / 32), I_DN = (FF / 64) * (D / 32), I_IN = (D / 64) * (NIN / 32), I_OUT = (D / 64) * (D / 32);
        constexpr int NITEMS = 4 * I_GU + 2 * I_DN + I_IN + I_OUT;
        for (int it = gw; it < NITEMS; it += NGW) {
            int r = it;
            if (r < I_GU) { transpose_seg(a.in[3], FF, D, FF / 32, WGU1, 1, r, scr, lane); continue; } r -= I_GU;
            if (r < I_GU) { transpose_seg(a.in[4], FF, D, FF / 32, WGU1, 2, r, scr, lane); continue; } r -= I_GU;
            if (r < I_DN) { transpose_seg(a.in[5], D, FF, D / 32, WD1, 0, r, scr, lane); continue; } r -= I_DN;
            if (r < I_GU) { transpose_seg(a.in[21], FF, D, FF / 32, WGU2, 1, r, scr, lane); continue; } r -= I_GU;
            if (r < I_GU) { transpose_seg(a.in[22], FF, D, FF / 32, WGU2, 2, r, scr, lane); continue; } r -= I_GU;
            if (r < I_DN) { transpose_seg(a.in[23], D, FF, D / 32, WD2, 0, r, scr, lane); continue; } r -= I_DN;
            if (r < I_IN) { transpose_seg(a.in[8], NINF, D, NIN / 32, WIN, 0, r, scr, lane); continue; } r -= I_IN;
            transpose_seg(a.in[18], D, D, D / 32, WOUT, 0, r, scr, lane);
        }
        for (int i = gt; i < 16 * D; i += NT) { const int j = i / D, k = i % D; WIN[(size_t)(NIN + j) * D + k] = f2bf1(a.in[8][(size_t)k * NINF + NIN + j]); }
        for (int i = gt; i < 8 * 128 * 128; i += NT) { const int t = (i >> 7) & 127, s = i & 127; WSP[i] = s <= t ? f2bf1(a.in[10][i]) : (unsigned short)0; }
        for (int i = gt; i < M; i += NT) VSS[i] = 0.f;
        row_pass<0>(gw, NGW, lane, nullptr, a.in[0], nullptr, 0.f, nullptr, a.in[1], XN);
    }
    GRID_SYNC();
    { pg8::Gemm g{XN, WGU1, M, NGU, D}; pg8::StaticOrder S; S.init(M, NGU, G, bx); pg8::EpiSwiGLU E{HB, FF};
      pg8::gemm_phase<pg8::EpiSwiGLU, pg8::StaticOrder>(lds, g, S, E, nullptr); }
    GRID_SYNC();
    { pg8::Gemm g{HB, WD1, M, D, FF}; pg8::StaticOrder S; S.init(M, D, G, bx); pg8::EpiF32 E{out, D, nullptr};
      pg8::gemm_phase<pg8::EpiF32, pg8::StaticOrder>(lds, g, S, E, nullptr); }
    GRID_SYNC();
    row_pass<1>(gw, NGW, lane, out, a.in[0], out, 0.5f, a.in[2], a.in[6], XN);
    GRID_SYNC();
    { pg8::Gemm g{XN, WIN, M, NIN, D}; pg8::StaticOrder S; S.init(M, NIN, G, bx); pg8::EpiInProj E{GU, GV, ZB, XBC, VSS};
      pg8::gemm_phase<pg8::EpiInProj, pg8::StaticOrder>(lds, g, S, E, nullptr); }
    for (int it = gw; it < M / 16; it += NGW) {
        const int r0 = it * 16; f32x4 acc = {0.f, 0.f, 0.f, 0.f};
        const bf16* wp = WIN + (size_t)(NIN + fr) * D + fq * 8; const bf16* xp = XN + (size_t)(r0 + fr) * D + fq * 8;
#pragma unroll 8
        for (int ks = 0; ks < D / 32; ++ks) { const bf16x8 wa = *(const bf16x8*)(wp + 32 * ks), xb = *(const bf16x8*)(xp + 32 * ks); acc = MFMA16(wa, xb, acc); }
        *(f32x4*)(DTRAW + (size_t)(r0 + fr) * 16 + 4 * fq) = acc;
    }
    GRID_SYNC();
    {
        const float* cw = a.in[12]; const float* cb = a.in[13];
        for (int idx = gt; idx < M * (XBCW / 8); idx += NT) {
            const int r = idx / (XBCW / 8), c8 = idx % (XBCW / 8), ch = c8 * 8, t = r & (SEQ - 1);
            const f32x4 b0 = *(const f32x4*)(cb + ch), b1 = *(const f32x4*)(cb + ch + 4);
            float acc[8] = {b0.x, b0.y, b0.z, b0.w, b1.x, b1.y, b1.z, b1.w};
#pragma unroll
            for (int k = 0; k < 4; ++k) {
                if (t - 3 + k >= 0) {
                    const v4u xv = *(const v4u*)(XBC + (size_t)(r - 3 + k) * XBCW + ch);
                    const f32x4 w0 = *(const f32x4*)(cw + k * XBCW + ch), w1 = *(const f32x4*)(cw + k * XBCW + ch + 4);
                    acc[0] += w0.x * bflo(xv.x); acc[1] += w0.y * bfhi(xv.x); acc[2] += w0.z * bflo(xv.y); acc[3] += w0.w * bfhi(xv.y);
                    acc[4] += w1.x * bflo(xv.z); acc[5] += w1.y * bfhi(xv.z); acc[6] += w1.z * bflo(xv.w); acc[7] += w1.w * bfhi(xv.w);
                }
            }
            v4u o; o.x = pk2(silu1(acc[0]), silu1(acc[1])); o.y = pk2(silu1(acc[2]), silu1(acc[3])); o.z = pk2(silu1(acc[4]), silu1(acc[5])); o.w = pk2(silu1(acc[6]), silu1(acc[7]));
            bf16* dst = ch < 1024 ? XS + (size_t)r * 1024 + ch : (ch < 1280 ? BMm + (size_t)r * 256 + (ch - 1024) : CMm + (size_t)r * 256 + (ch - 1280));
            *(v4u*)dst = o;
        }
        for (int i = gt; i < M * 16; i += NT) { const float v = DTRAW[i] + a.in[14][i & 15]; DT[i] = fmaxf(v, 0.f) + log1pf(__expf(-fabsf(v))); }
        LAS unsigned short* vnT = (LAS unsigned short*)lds;
        LAS float* rsv = (LAS float*)(lds + 128 * 136 * 2);
        for (int u = bx; u < 1024; u += G) {
            const int hh = u & 7, rowbase = (u >> 3) * 128;
            if (tid < 128) rsv[tid] = __frsqrt_rn(VSS[rowbase + tid] * (1.0f / AW) + EPS);
            __syncthreads();
#pragma unroll
            for (int i = 0; i < 4; ++i) {
                const int q = tid + 512 * i, s = q >> 4, dc = q & 15;
                const v4u raw = *(const v4u*)(GV + (size_t)(rowbase + s) * AW + hh * 128 + 8 * dc);
                const f32x4 g0 = *(const f32x4*)(a.in[9] + hh * 128 + 8 * dc), g1 = *(const f32x4*)(a.in[9] + hh * 128 + 8 * dc + 4);
                const float rs = rsv[s];
                LAS unsigned short* dstp = vnT + (8 * dc) * 136 + s;
                dstp[0 * 136] = f2bf1(bflo(raw.x) * rs * g0.x); dstp[1 * 136] = f2bf1(bfhi(raw.x) * rs * g0.y);
                dstp[2 * 136] = f2bf1(bflo(raw.y) * rs * g0.z); dstp[3 * 136] = f2bf1(bfhi(raw.y) * rs * g0.w);
                dstp[4 * 136] = f2bf1(bflo(raw.z) * rs * g1.x); dstp[5 * 136] = f2bf1(bfhi(raw.z) * rs * g1.y);
                dstp[6 * 136] = f2bf1(bflo(raw.w) * rs * g1.z); dstp[7 * 136] = f2bf1(bfhi(raw.w) * rs * g1.w);
            }
            __syncthreads();
            f32x4 acc[8];
#pragma unroll
            for (int df = 0; df < 8; ++df) acc[df] = (f32x4){0.f, 0.f, 0.f, 0.f};
            const int kmax = (wave >> 1) + 1;
            const bf16* wsp = WSP + (size_t)hh * 16384 + (16 * wave + fr) * 128 + 8 * fq;
            for (int ks = 0; ks < kmax; ++ks) {
                const bf16x8 wb = *(const bf16x8*)(wsp + 32 * ks);
#pragma unroll
                for (int df = 0; df < 8; ++df) { const bf16x8 va = *(const LAS bf16x8*)(vnT + (16 * df + fr) * 136 + 32 * ks + 8 * fq); acc[df] = MFMA16(va, wb, acc[df]); }
            }
            const int row = rowbase + 16 * wave + fr; const float bsv = a.in[11][hh * 128 + 16 * wave + fr];
#pragma unroll
            for (int df = 0; df < 8; ++df) {
                const int col = hh * 128 + 16 * df + 4 * fq;
                const v2u gu = *(const v2u*)(GU + (size_t)row * AW + col);
                v2u o; o.x = pk2(bflo(gu.x) * (acc[df][0] + bsv), bfhi(gu.x) * (acc[df][1] + bsv)); o.y = pk2(bflo(gu.y) * (acc[df][2] + bsv), bfhi(gu.y) * (acc[df][3] + bsv));
                *(v2u*)(YCAT + (size_t)row * D + col) = o;
            }
            __syncthreads();
        }
    }
    GRID_SYNC();
    {
        LAS float* acsL = (LAS float*)lds;
        LAS float* dtL = (LAS float*)(lds + 1024);
        LAS float* wtot = (LAS float*)(lds + 2048);
        LAS unsigned short* xT = (LAS unsigned short*)(lds + 4096);
        LAS unsigned short* bT = (LAS unsigned short*)(lds + 4096 + 64 * 264 * 2);
        for (int u = bx; u < 1024; u += G) {
            const int h = u & 15, bc = u >> 4, g = h >> 3, rowc = bc * 256;
            const float ah = -__expf(a.in[15][h]);
            float v = 0.f, dtv = 0.f;
            if (tid < 256) {
                dtv = DT[(size_t)(rowc + tid) * 16 + h]; v = dtv * ah;
#pragma unroll
                for (int o = 1; o < 64; o <<= 1) { const float t = __shfl_up(v, o); if (lane >= o) v += t; }
                if (lane == 63) wtot[wave] = v;
            }
            __syncthreads();
            if (tid < 256) {
                float add = 0.f;
                for (int w = 0; w < 4; ++w) if (w < wave) add += wtot[w];
                v += add; acsL[tid] = v; dtL[tid] = dtv; ACS[(size_t)(rowc + tid) * 16 + h] = v;
            }
            __syncthreads();
            const float alast = acsL[255];
#pragma unroll
            for (int i = 0; i < 4; ++i) {
                const int q = tid + 512 * i, l = q >> 3, pc = q & 7;
                const v4u raw = *(const v4u*)(XS + (size_t)(rowc + l) * 1024 + h * 64 + 8 * pc);
                const float d = dtL[l];
                LAS unsigned short* dstp = xT + (8 * pc) * 264 + l;
                dstp[0 * 264] = f2bf1(bflo(raw.x) * d); dstp[1 * 264] = f2bf1(bfhi(raw.x) * d); dstp[2 * 264] = f2bf1(bflo(raw.y) * d); dstp[3 * 264] = f2bf1(bfhi(raw.y) * d);
                dstp[4 * 264] = f2bf1(bflo(raw.z) * d); dstp[5 * 264] = f2bf1(bfhi(raw.z) * d); dstp[6 * 264] = f2bf1(bflo(raw.w) * d); dstp[7 * 264] = f2bf1(bfhi(raw.w) * d);
            }
#pragma unroll
            for (int i = 0; i < 8; ++i) {
                const int q = tid + 512 * i, l = q >> 4, nc = q & 15;
                const v4u raw = *(const v4u*)(BMm + (size_t)(rowc + l) * 256 + g * 128 + 8 * nc);
                const float d = __expf(alast - acsL[l]);
                LAS unsigned short* dstp = bT + (8 * nc) * 264 + l;
                dstp[0 * 264] = f2bf1(bflo(raw.x) * d); dstp[1 * 264] = f2bf1(bfhi(raw.x) * d); dstp[2 * 264] = f2bf1(bflo(raw.y) * d); dstp[3 * 264] = f2bf1(bfhi(raw.y) * d);
                dstp[4 * 264] = f2bf1(bflo(raw.z) * d); dstp[5 * 264] = f2bf1(bfhi(raw.z) * d); dstp[6 * 264] = f2bf1(bflo(raw.w) * d); dstp[7 * 264] = f2bf1(bfhi(raw.w) * d);
            }
            __syncthreads();
#pragma unroll
            for (int i = 0; i < 4; ++i) {
                const int q = tid + 512 * i, p = q >> 5, lc = q & 31;
                *(v4u*)(XDTT + (size_t)u * 16384 + p * 256 + 8 * lc) = *(const LAS v4u*)(xT + p * 264 + 8 * lc);
            }
            f32x4 acc[4];
#pragma unroll
            for (int pf = 0; pf < 4; ++pf) acc[pf] = (f32x4){0.f, 0.f, 0.f, 0.f};
#pragma unroll
            for (int ks = 0; ks < 8; ++ks) {
                const bf16x8 ba = *(const LAS bf16x8*)(bT + (16 * wave + fr) * 264 + 32 * ks + 8 * fq);
#pragma unroll
                for (int pf = 0; pf < 4; ++pf) { const bf16x8 xb = *(const LAS bf16x8*)(xT + (16 * pf + fr) * 264 + 32 * ks + 8 * fq); acc[pf] = MFMA16(ba, xb, acc[pf]); }
            }
#pragma unroll
            for (int pf = 0; pf < 4; ++pf) *(f32x4*)(ST + (size_t)u * 8192 + (16 * pf + fr) * 128 + 16 * wave + 4 * fq) = acc[pf];
            __syncthreads();
        }
    }
    GRID_SYNC();
    for (int vi = gt; vi < 65536; vi += NT) {
        const int e4 = vi * 4, n = e4 & 127, p = (e4 >> 7) & 63, h = (e4 >> 13) & 15, b = e4 >> 17;
        f32x4 carry = {0.f, 0.f, 0.f, 0.f};
        for (int c = 0; c < 32; ++c) {
            const size_t off = (size_t)((b * 32 + c) * 16 + h) * 8192 + p * 128 + n;
            v2u o; o.x = pk2(carry.x, carry.y); o.y = pk2(carry.z, carry.w);
            *(v2u*)(PREV + off) = o;
            const float dec = __expf(ACS[(size_t)(b * SEQ + c * 256 + 255) * 16 + h]);
            carry = carry * dec + *(const f32x4*)(ST + off);
        }
    }
    GRID_SYNC();
    {
        LAS float* CB = (LAS float*)lds;
        LAS float* acsL = (LAS float*)(lds + 64 * 260 * 4);
        LAS float* ssL = (LAS float*)(lds + 64 * 260 * 4 + 8192);
        for (int u = bx; u < 512; u += G) {
            const int lb = u & 3, g = (u >> 2) & 1, bc = u >> 3, rowc = bc * 256, l0 = lb * 64, S = l0 + 64;
            for (int sf = wave; sf < S / 16; sf += 8) {
                f32x4 cacc[4];
#pragma unroll
                for (int lf = 0; lf < 4; ++lf) cacc[lf] = (f32x4){0.f, 0.f, 0.f, 0.f};
#pragma unroll
                for (int ks = 0; ks < 4; ++ks) {
                    const bf16x8 ba = *(const bf16x8*)(BMm + (size_t)(rowc + 16 * sf + fr) * 256 + g * 128 + 32 * ks + 8 * fq);
#pragma unroll
                    for (int lf = 0; lf < 4; ++lf) { const bf16x8 cbv = *(const bf16x8*)(CMm + (size_t)(rowc + l0 + 16 * lf + fr) * 256 + g * 128 + 32 * ks + 8 * fq); cacc[lf] = MFMA16(ba, cbv, cacc[lf]); }
                }
#pragma unroll
                for (int lf = 0; lf < 4; ++lf) *(LAS f32x4*)(CB + (16 * lf + fr) * 260 + 16 * sf + 4 * fq) = cacc[lf];
            }
#pragma unroll
            for (int i = 0; i < 4; ++i) { const int q = tid + 512 * i, hh = q >> 8, l = q & 255; acsL[q] = ACS[(size_t)(rowc + l) * 16 + g * 8 + hh]; }
            __syncthreads();
            const int hh = wave, h = g * 8 + hh; const size_t uh = (size_t)(bc * 16 + h);
            f32x4 acc[4][4];
#pragma unroll
            for (int pf = 0; pf < 4; ++pf)
#pragma unroll
                for (int lf = 0; lf < 4; ++lf) acc[pf][lf] = (f32x4){0.f, 0.f, 0.f, 0.f};
#pragma unroll
            for (int ks = 0; ks < 4; ++ks) {
                bf16x8 pa[4];
#pragma unroll
                for (int pf = 0; pf < 4; ++pf) pa[pf] = *(const bf16x8*)(PREV + uh * 8192 + (16 * pf + fr) * 128 + 32 * ks + 8 * fq);
#pragma unroll
                for (int lf = 0; lf < 4; ++lf) { const bf16x8 cbv = *(const bf16x8*)(CMm + (size_t)(rowc + l0 + 16 * lf + fr) * 256 + g * 128 + 32 * ks + 8 * fq);
#pragma unroll
                    for (int pf = 0; pf < 4; ++pf) acc[pf][lf] = MFMA16(pa[pf], cbv, acc[pf][lf]); }
            }
            float al[4];
#pragma unroll
            for (int lf = 0; lf < 4; ++lf) { al[lf] = acsL[hh * 256 + l0 + 16 * lf + fr]; const float e = __expf(al[lf]);
#pragma unroll
                for (int pf = 0; pf < 4; ++pf) acc[pf][lf] = acc[pf][lf] * e; }
            for (int ks = 0; ks < S / 32; ++ks) {
                const int s0 = 32 * ks + 8 * fq;
                bf16x8 xa[4];
#pragma unroll
                for (int pf = 0; pf < 4; ++pf) xa[pf] = *(const bf16x8*)(XDTT + uh * 16384 + (16 * pf + fr) * 256 + s0);
                const f32x4 as0 = *(const LAS f32x4*)(acsL + hh * 256 + s0), as1 = *(const LAS f32x4*)(acsL + hh * 256 + s0 + 4);
#pragma unroll
                for (int lf = 0; lf < 4; ++lf) {
                    if (32 * ks > l0 + 16 * lf + 15) continue;
                    const int l = l0 + 16 * lf + fr;
                    const f32x4 c0 = *(const LAS f32x4*)(CB + (16 * lf + fr) * 260 + s0), c1 = *(const LAS f32x4*)(CB + (16 * lf + fr) * 260 + s0 + 4);
                    const float a_l = al[lf];
                    const float m0 = (s0 + 0 <= l) ? c0.x * __expf(a_l - as0.x) : 0.f, m1 = (s0 + 1 <= l) ? c0.y * __expf(a_l - as0.y) : 0.f;
                    const float m2 = (s0 + 2 <= l) ? c0.z * __expf(a_l - as0.z) : 0.f, m3 = (s0 + 3 <= l) ? c0.w * __expf(a_l - as0.w) : 0.f;
                    const float m4 = (s0 + 4 <= l) ? c1.x * __expf(a_l - as1.x) : 0.f, m5 = (s0 + 5 <= l) ? c1.y * __expf(a_l - as1.y) : 0.f;
                    const float m6 = (s0 + 6 <= l) ? c1.z * __expf(a_l - as1.z) : 0.f, m7 = (s0 + 7 <= l) ? c1.w * __expf(a_l - as1.w) : 0.f;
                    v4u mw; mw.x = pk2(m0, m1); mw.y = pk2(m2, m3); mw.z = pk2(m4, m5); mw.w = pk2(m6, m7);
                    const bf16x8 mb = __builtin_bit_cast(bf16x8, mw);
#pragma unroll
                    for (int pf = 0; pf < 4; ++pf) acc[pf][lf] = MFMA16(xa[pf], mb, acc[pf][lf]);
                }
            }
            const float Dh = a.in[16][h];
            float ssq[4];
#pragma unroll
            for (int lf = 0; lf < 4; ++lf) {
                const size_t row = (size_t)(rowc + l0 + 16 * lf + fr); float s2 = 0.f;
#pragma unroll
                for (int pf = 0; pf < 4; ++pf) {
                    const int chn = h * 64 + 16 * pf + 4 * fq;
                    const v2u xv = *(const v2u*)(XS + row * 1024 + chn), zv = *(const v2u*)(ZB + row * 1024 + chn);
                    f32x4 y = acc[pf][lf];
                    y.x = (y.x + Dh * bflo(xv.x)) * bflo(zv.x); y.y = (y.y + Dh * bfhi(xv.x)) * bfhi(zv.x); y.z = (y.z + Dh * bflo(xv.y)) * bflo(zv.y); y.w = (y.w + Dh * bfhi(xv.y)) * bfhi(zv.y);
                    acc[pf][lf] = y; s2 += (y.x * y.x + y.y * y.y) + (y.z * y.z + y.w * y.w);
                }
                s2 += __shfl_xor(s2, 16); s2 += __shfl_xor(s2, 32); ssq[lf] = s2;
                if (fq == 0) ssL[hh * 64 + 16 * lf + fr] = s2;
            }
            __syncthreads();
#pragma unroll
            for (int lf = 0; lf < 4; ++lf) {
                float tot = 0.f;
#pragma unroll
                for (int w = 0; w < 8; ++w) tot += ssL[w * 64 + 16 * lf + fr];
                const float rs = __frsqrt_rn(tot * (1.0f / 512.0f) + EPS);
                const size_t row = (size_t)(rowc + l0 + 16 * lf + fr);
#pragma unroll
                for (int pf = 0; pf < 4; ++pf) {
                    const int chn = h * 64 + 16 * pf + 4 * fq;
                    const f32x4 gn = *(const f32x4*)(a.in[17] + chn); const f32x4 y = acc[pf][lf];
                    v2u o; o.x = pk2(y.x * rs * gn.x, y.y * rs * gn.y); o.y = pk2(y.z * rs * gn.z, y.w * rs * gn.w);
                    *(v2u*)(YCAT + row * D + 1024 + chn) = o;
                }
            }
            __syncthreads();
        }
    }
    GRID_SYNC();
    { pg8::Gemm g{YCAT, WOUT, M, D, D}; pg8::StaticOrder S; S.init(M, D, G, bx); pg8::EpiF32 E{HF2, D, nullptr};
      pg8::gemm_phase<pg8::EpiF32, pg8::StaticOrder>(lds, g, S, E, nullptr); }
    GRID_SYNC();
    row_pass<1>(gw, NGW, lane, HF2, out, out, 1.0f, a.in[7], a.in[19], XN);
    GRID_SYNC();
    { pg8::Gemm g{XN, WGU2, M, NGU, D}; pg8::StaticOrder S; S.init(M, NGU, G, bx); pg8::EpiSwiGLU E{HB, FF};
      pg8::gemm_phase<pg8::EpiSwiGLU, pg8::StaticOrder>(lds, g, S, E, nullptr); }
    GRID_SYNC();
    { pg8::Gemm g{HB, WD2, M, D, FF}; pg8::StaticOrder S; S.init(M, D, G, bx); pg8::EpiF32 E{HF3, D, nullptr};
      pg8::gemm_phase<pg8::EpiF32, pg8::StaticOrder>(lds, g, S, E, nullptr); }
    GRID_SYNC();
    row_pass<2>(gw, NGW, lane, HF3, out, out, 0.5f, a.in[20], nullptr, nullptr);
}

extern "C" void kernel_launch(void* const* d_in, const int* in_sizes, int n_in, void* d_out, int out_size, void* d_ws, size_t ws_size, hipStream_t stream) {
    static int grid = 0;
    if (grid == 0) {
        if (n_in != 24 || out_size != M * D || ws_size < WS_END) { fprintf(stderr, "kernel_launch: unexpected shapes (n_in %d out %d ws %zu)\n", n_in, out_size, ws_size); grid = -1; return; }
        int dev = 0, cus = 0, per_cu = 0;
        hipGetDevice(&dev); hipDeviceGetAttribute(&cus, hipDeviceAttributeMultiprocessorCount, dev);
        if (hipFuncSetAttribute((const void*)fwd_mega, hipFuncAttributeMaxDynamicSharedMemorySize, LDS_BYTES) != hipSuccess) { fprintf(stderr, "kernel_launch: hipFuncSetAttribute failed\n"); grid = -1; return; }
        if (hipOccupancyMaxActiveBlocksPerMultiprocessor(&per_cu, (const void*)fwd_mega, 512, LDS_BYTES) != hipSuccess || per_cu < 1) { fprintf(stderr, "kernel_launch: occupancy query gave %d\n", per_cu); per_cu = 1; }
        (void)hipGetLastError();
        grid = cus * 1;
    }
    if (grid < 0) return;
    Args a{};
    for (int i = 0; i < 24; ++i) a.in[i] = (const float*)d_in[i];
    a.out = (float*)d_out; a.ws = (unsigned char*)d_ws;
    void* args[] = {&a};
    hipError_t e = hipLaunchCooperativeKernel((const void*)fwd_mega, dim3(grid), dim3(512), args, LDS_BYTES, stream);
    if (e != hipSuccess) fprintf(stderr, "cooperative launch failed: %s (grid %d)\n", hipGetErrorString(e), grid);
}
```

```cpp
#include <hip/hip_runtime.h>
#include <hip/hip_cooperative_groups.h>
#include <cstdio>
namespace cg = cooperative_groups;
namespace pg8 {
#define PG8_LAS __attribute__((address_space(3)))
typedef unsigned short bf16_t;
typedef short bf16x8 __attribute__((ext_vector_type(8)));
typedef float f32x4 __attribute__((ext_vector_type(4)));
typedef unsigned u32x4 __attribute__((ext_vector_type(4)));
constexpr int BM = 256, BK = 64, HALF = 128, HTB = HALF * BK * 2  , STAGE_BYTES = 8 * HTB, NXCD = 8, WGM = 8;

__host__ __device__ __forceinline__ int lds_byte(int r, int c) { const int st = (r >> 4) * 2 + (c >> 5), rr = r & 15, cc = c & 31, ob = rr * 64 + cc * 2; return st * 1024 + (ob ^ (((ob >> 9) & 1) << 5)); }
__host__ __device__ __forceinline__ void stage_rc(int b, int& R, int& C) { const int st = b / 1024, sb = b % 1024, swz = sb ^ (((sb >> 9) & 1) << 5); R = (st >> 1) * 16 + swz / 64; C = (st & 1) * 32 + (swz % 64) / 2; }
__host__ __device__ __forceinline__ int perm32(int rho) { const int n = rho >> 4, i = rho & 15; return 8 * (i >> 2) + 4 * n + (i & 3); }

struct Unit { int pm, pn; };
struct Gemm { const bf16_t* A; const bf16_t* Bt; int M, N, K; };

struct StaticOrder {
    int nM, nN, nwg, G, c;
    __host__ __device__ void init(int M, int N, int G_, int c_) { nM = M / BM; nN = N / BM; nwg = nM * nN; G = G_; c = c_; }
    __host__ __device__ bool next(int i, Unit& u) const {
        const long L = (long)i * G + c; if (L >= nwg) return false;
        int wgid = (int)L; { const int q = nwg / NXCD, r = nwg % NXCD, xcd = wgid % NXCD, off = wgid / NXCD; wgid = (xcd < r ? xcd * (q + 1) : r * (q + 1) + (xcd - r) * q) + off; }
        const int nig = WGM * nN, gid = wgid / nig, fm = gid * WGM, gsz = (nM - fm) < WGM ? (nM - fm) : WGM;
        u.pm = fm + ((wgid % nig) % gsz); u.pn = (wgid % nig) / gsz; return true;
    }
    __device__ __forceinline__ void a_ready(const Unit&) const {}
    __device__ __forceinline__ void done(const Unit&) const {}
};
struct CountedOrder : StaticOrder {
    const unsigned* ready; unsigned need; unsigned* tmo;
    __device__ __forceinline__ void a_ready(const Unit& u) const {
        if (threadIdx.x < 64) {
            const unsigned long long t0 = __builtin_amdgcn_s_memrealtime(); unsigned polls = 0;
            while ((unsigned)__builtin_amdgcn_readfirstlane(__hip_atomic_load(ready + 64 * u.pm, __ATOMIC_RELAXED, __HIP_MEMORY_SCOPE_AGENT)) < need) {
                if ((++polls & 255u) == 0u && __builtin_amdgcn_readfirstlane(__hip_atomic_load(tmo, __ATOMIC_RELAXED, __HIP_MEMORY_SCOPE_AGENT)) != 0u) break;
                if (__builtin_amdgcn_s_memrealtime() - t0 > 2000000ull) {
                    if (threadIdx.x == 0) { unsigned expect = 0u; __hip_atomic_compare_exchange_strong(tmo + 1, &expect, 0x600u | (unsigned)(u.pm & 0xff), __ATOMIC_RELAXED, __ATOMIC_RELAXED, __HIP_MEMORY_SCOPE_AGENT); __hip_atomic_store(tmo, 1u, __ATOMIC_RELAXED, __HIP_MEMORY_SCOPE_AGENT); }
                    break; }
                __builtin_amdgcn_s_sleep(2); }
            __builtin_amdgcn_fence(__ATOMIC_ACQUIRE, "agent");
            asm volatile("s_waitcnt vmcnt(0)" ::: "memory");
        }
#if !defined(BROKEN_HOOK_NO_BARRIER)
        asm volatile("" ::: "memory"); __builtin_amdgcn_s_barrier(); asm volatile("" ::: "memory");
#endif
    }
};

__device__ __forceinline__ unsigned cvt_pk_bf16(float lo, float hi) { unsigned r; asm volatile("v_cvt_pk_bf16_f32 %0, %1, %2" : "=v"(r) : "v"(lo), "v"(hi)); return r; }
typedef float f32x2 __attribute__((ext_vector_type(2)));
__device__ __forceinline__ f32x2 gelu_pk(f32x2 v) {
    const f32x2 av = __builtin_elementwise_abs(v), d = av * 0.2316418882f + 1.0f;
    f32x2 t; t.x = __builtin_amdgcn_rcpf(d.x); t.y = __builtin_amdgcn_rcpf(d.y);
    f32x2 q = t * 0.5307027145f + (-0.7265760135f); q = q * t + 0.7107068705f; q = q * t + (-0.142248368f); q = q * t + 0.127414796f; q = q * t;
    const f32x2 s = (v * v) * (-0.72134752044f);
    f32x2 e; e.x = __builtin_amdgcn_exp2f(s.x); e.y = __builtin_amdgcn_exp2f(s.y);
    const f32x2 m = v * (q * e), r = v - m;
    f32x2 o; o.x = v.x < 0.f ? m.x : r.x; o.y = v.y < 0.f ? m.y : r.y; return o;
}

struct EpiF32 {
    static constexpr bool PERM = false, AFTER_DRAIN = false;
    float* C; int ldc; const float* bias;
    __device__ __forceinline__ void operator()(const f32x4 (&acc)[2][2][4][2], const Unit& u, int wr, int wc, int fr, int fq) const {
        const int row0 = u.pm * BM + wr * 64 + fr, col0 = u.pn * BM + wc * 32 + 4 * fq;
        f32x4 bv[2][2];
#pragma unroll
        for (int bj = 0; bj < 2; ++bj)
#pragma unroll
            for (int n = 0; n < 2; ++n) bv[bj][n] = bias ? *(const f32x4*)(bias + col0 + bj * HALF + n * 16) : (f32x4){0.f, 0.f, 0.f, 0.f};
#pragma unroll
        for (int ai = 0; ai < 2; ++ai)
#pragma unroll
            for (int m = 0; m < 4; ++m) { float* rowp = C + (size_t)(row0 + ai * HALF + m * 16) * ldc + col0;
#pragma unroll
                for (int bj = 0; bj < 2; ++bj)
#pragma unroll
                    for (int n = 0; n < 2; ++n) *(f32x4*)(rowp + bj * HALF + n * 16) = acc[ai][bj][m][n] + bv[bj][n]; }
    }
};
}
namespace pg8 {
__device__ __forceinline__ float silu_f(float g) { return g * __builtin_amdgcn_rcpf(1.0f + __expf(-g)); }
__device__ __forceinline__ void gelu_pk4(f32x2& a, f32x2& b, f32x2& c, f32x2& d) {
    const f32x2 aa = __builtin_elementwise_abs(a), ab = __builtin_elementwise_abs(b), ac = __builtin_elementwise_abs(c), ad = __builtin_elementwise_abs(d);
    const f32x2 da = aa * 0.2316418882f + 1.0f, db = ab * 0.2316418882f + 1.0f, dc = ac * 0.2316418882f + 1.0f, dd = ad * 0.2316418882f + 1.0f;
    f32x2 ta, tb, tc, td;
    ta.x = __builtin_amdgcn_rcpf(da.x); ta.y = __builtin_amdgcn_rcpf(da.y); tb.x = __builtin_amdgcn_rcpf(db.x); tb.y = __builtin_amdgcn_rcpf(db.y);
    tc.x = __builtin_amdgcn_rcpf(dc.x); tc.y = __builtin_amdgcn_rcpf(dc.y); td.x = __builtin_amdgcn_rcpf(dd.x); td.y = __builtin_amdgcn_rcpf(dd.y);
    const f32x2 sa = (a * a) * (-0.72134752044f), sb = (b * b) * (-0.72134752044f), sc = (c * c) * (-0.72134752044f), sd = (d * d) * (-0.72134752044f);
    f32x2 ea, eb, ec, ed;
    ea.x = __builtin_amdgcn_exp2f(sa.x); ea.y = __builtin_amdgcn_exp2f(sa.y); eb.x = __builtin_amdgcn_exp2f(sb.x); eb.y = __builtin_amdgcn_exp2f(sb.y);
    ec.x = __builtin_amdgcn_exp2f(sc.x); ec.y = __builtin_amdgcn_exp2f(sc.y); ed.x = __builtin_amdgcn_exp2f(sd.x); ed.y = __builtin_amdgcn_exp2f(sd.y);
    f32x2 qa = ta * 0.5307027145f + (-0.7265760135f), qb = tb * 0.5307027145f + (-0.7265760135f), qc = tc * 0.5307027145f + (-0.7265760135f), qd = td * 0.5307027145f + (-0.7265760135f);
    qa = qa * ta + 0.7107068705f; qb = qb * tb + 0.7107068705f; qc = qc * tc + 0.7107068705f; qd = qd * td + 0.7107068705f;
    qa = qa * ta + (-0.142248368f); qb = qb * tb + (-0.142248368f); qc = qc * tc + (-0.142248368f); qd = qd * td + (-0.142248368f);
    qa = qa * ta + 0.127414796f; qb = qb * tb + 0.127414796f; qc = qc * tc + 0.127414796f; qd = qd * td + 0.127414796f;
    qa = qa * ta; qb = qb * tb; qc = qc * tc; qd = qd * td;
    const f32x2 ma = a * (qa * ea), mb = b * (qb * eb), mc = c * (qc * ec), md = d * (qd * ed);
    const f32x2 ra = a - ma, rb = b - mb, rc = c - mc, rd = d - md;
    f32x2 oa, ob, oc, od;
    oa.x = a.x < 0.f ? ma.x : ra.x; oa.y = a.y < 0.f ? ma.y : ra.y; ob.x = b.x < 0.f ? mb.x : rb.x; ob.y = b.y < 0.f ? mb.y : rb.y;
    oc.x = c.x < 0.f ? mc.x : rc.x; oc.y = c.y < 0.f ? mc.y : rc.y; od.x = d.x < 0.f ? md.x : rd.x; od.y = d.y < 0.f ? md.y : rd.y;
    a = oa; b = ob; c = oc; d = od;
}
__device__ __forceinline__ void silu_pk4(f32x2& a, f32x2& b, f32x2& c, f32x2& d) {
    const f32x2 ta = a * -1.44269504f, tb = b * -1.44269504f, tc = c * -1.44269504f, td = d * -1.44269504f;
    f32x2 ea, eb, ec, ed;
    ea.x = __builtin_amdgcn_exp2f(ta.x); ea.y = __builtin_amdgcn_exp2f(ta.y); eb.x = __builtin_amdgcn_exp2f(tb.x); eb.y = __builtin_amdgcn_exp2f(tb.y);
    ec.x = __builtin_amdgcn_exp2f(tc.x); ec.y = __builtin_amdgcn_exp2f(tc.y); ed.x = __builtin_amdgcn_exp2f(td.x); ed.y = __builtin_amdgcn_exp2f(td.y);
    ea = ea + 1.0f; eb = eb + 1.0f; ec = ec + 1.0f; ed = ed + 1.0f;
    f32x2 ra, rb, rc, rd;
    ra.x = __builtin_amdgcn_rcpf(ea.x); ra.y = __builtin_amdgcn_rcpf(ea.y); rb.x = __builtin_amdgcn_rcpf(eb.x); rb.y = __builtin_amdgcn_rcpf(eb.y);
    rc.x = __builtin_amdgcn_rcpf(ec.x); rc.y = __builtin_amdgcn_rcpf(ec.y); rd.x = __builtin_amdgcn_rcpf(ed.x); rd.y = __builtin_amdgcn_rcpf(ed.y);
    a = a * ra; b = b * rb; c = c * rc; d = d * rd;
}
struct EpiSwiGLU {
    static constexpr bool PERM = true, AFTER_DRAIN = false;
    bf16_t* O; int ldc;
    __device__ __forceinline__ void operator()(const f32x4 (&acc)[2][2][4][2], const Unit& u, int wr, int wc, int fr, int fq) const {
        const int row0 = u.pm * BM + wr * 64 + fr, col0 = u.pn * 128 + wc * 32 + 8 * fq;
#pragma unroll
        for (int ai = 0; ai < 2; ++ai)
#pragma unroll
            for (int m = 0; m < 4; ++m) {
                bf16_t* rowp = O + (size_t)(row0 + ai * HALF + m * 16) * ldc + col0;
                const f32x4 g0 = acc[ai][0][m][0], g1 = acc[ai][0][m][1], u0 = acc[ai][1][m][0], u1 = acc[ai][1][m][1];
                f32x2 ga = {g0[0], g0[1]}, gb = {g0[2], g0[3]}, gc = {g1[0], g1[1]}, gd = {g1[2], g1[3]};
                f32x2 ta = ga * -1.44269504f, tb = gb * -1.44269504f, tc = gc * -1.44269504f, td = gd * -1.44269504f;
                f32x2 ea, eb, ec, ed;
                ea.x = __builtin_amdgcn_exp2f(ta.x); ea.y = __builtin_amdgcn_exp2f(ta.y); eb.x = __builtin_amdgcn_exp2f(tb.x); eb.y = __builtin_amdgcn_exp2f(tb.y);
                ec.x = __builtin_amdgcn_exp2f(tc.x); ec.y = __builtin_amdgcn_exp2f(tc.y); ed.x = __builtin_amdgcn_exp2f(td.x); ed.y = __builtin_amdgcn_exp2f(td.y);
                ea = ea + 1.0f; eb = eb + 1.0f; ec = ec + 1.0f; ed = ed + 1.0f;
                f32x2 pa = ga * (f32x2){u0[0], u0[1]}, pb = gb * (f32x2){u0[2], u0[3]}, pc = gc * (f32x2){u1[0], u1[1]}, pd = gd * (f32x2){u1[2], u1[3]};
                f32x2 ra, rb, rc, rd;
                ra.x = __builtin_amdgcn_rcpf(ea.x); ra.y = __builtin_amdgcn_rcpf(ea.y); rb.x = __builtin_amdgcn_rcpf(eb.x); rb.y = __builtin_amdgcn_rcpf(eb.y);
                rc.x = __builtin_amdgcn_rcpf(ec.x); rc.y = __builtin_amdgcn_rcpf(ec.y); rd.x = __builtin_amdgcn_rcpf(ed.x); rd.y = __builtin_amdgcn_rcpf(ed.y);
                pa = pa * ra; pb = pb * rb; pc = pc * rc; pd = pd * rd;
                u32x4 w;
                w.x = cvt_pk_bf16(pa.x, pa.y); w.y = cvt_pk_bf16(pb.x, pb.y); w.z = cvt_pk_bf16(pc.x, pc.y); w.w = cvt_pk_bf16(pd.x, pd.y);
                *(u32x4*)rowp = w;
            }
    }
};
struct EpiBf16P {
    static constexpr bool PERM = true, AFTER_DRAIN = false;
    bf16_t* O; int ldc;
    __device__ __forceinline__ void operator()(const f32x4 (&acc)[2][2][4][2], const Unit& u, int wr, int wc, int fr, int fq) const {
        const int row0 = u.pm * BM + wr * 64 + fr, col0 = u.pn * BM + wc * 32 + 8 * fq;
#pragma unroll
        for (int ai = 0; ai < 2; ++ai)
#pragma unroll
            for (int m = 0; m < 4; ++m) { bf16_t* rowp = O + (size_t)(row0 + ai * HALF + m * 16) * ldc + col0;
#pragma unroll
                for (int bj = 0; bj < 2; ++bj) { const f32x4 v0 = acc[ai][bj][m][0], v1 = acc[ai][bj][m][1];
                    u32x4 w; w.x = cvt_pk_bf16(v0[0], v0[1]); w.y = cvt_pk_bf16(v0[2], v0[3]); w.z = cvt_pk_bf16(v1[0], v1[1]); w.w = cvt_pk_bf16(v1[2], v1[3]);
                    *(u32x4*)(rowp + bj * HALF) = w; } }
    }
};
struct EpiHS {
    static constexpr bool PERM = true, AFTER_DRAIN = false;
    bf16_t* O; int ldc; float* HQ;
    __device__ __forceinline__ void operator()(const f32x4 (&acc)[2][2][4][2], const Unit& u, int wr, int wc, int fr, int fq) const {
        const int row0 = u.pm * BM + wr * 64 + fr, col0 = u.pn * BM + wc * 32 + 8 * fq;
#pragma unroll
        for (int ai = 0; ai < 2; ++ai)
#pragma unroll
            for (int m = 0; m < 4; ++m) { bf16_t* rowp = O + (size_t)(row0 + ai * HALF + m * 16) * ldc + col0; float ssq = 0.f;
#pragma unroll
                for (int bj = 0; bj < 2; ++bj) { const f32x4 v0 = acc[ai][bj][m][0], v1 = acc[ai][bj][m][1];
                    ssq += (v0[0] * v0[0] + v0[1] * v0[1]) + (v0[2] * v0[2] + v0[3] * v0[3]) + (v1[0] * v1[0] + v1[1] * v1[1]) + (v1[2] * v1[2] + v1[3] * v1[3]);
                    u32x4 w; w.x = cvt_pk_bf16(v0[0], v0[1]); w.y = cvt_pk_bf16(v0[2], v0[3]); w.z = cvt_pk_bf16(v1[0], v1[1]); w.w = cvt_pk_bf16(v1[2], v1[3]);
                    *(u32x4*)(rowp + bj * HALF) = w; }
                ssq += __shfl_xor(ssq, 16); ssq += __shfl_xor(ssq, 32);
                if (fq == 0) __hip_atomic_fetch_add(HQ + (((u.pm * 2 + wr) * 16 + fr) * 8 + ai * 4 + m), ssq, __ATOMIC_RELAXED, __HIP_MEMORY_SCOPE_AGENT); }
    }
};
struct EpiInProj {
    static constexpr bool PERM = true, AFTER_DRAIN = false;
    bf16_t *GU, *GV, *Z, *XBC; float* vss;
    __device__ __forceinline__ void operator()(const f32x4 (&acc)[2][2][4][2], const Unit& u, int wr, int wc, int fr, int fq) const {
        const int pn = u.pn; const int row0 = u.pm * BM + wr * 64 + fr;
        bf16_t* base; int ldc, colt, mode;
        if (pn < 4) { base = GU; ldc = 1024; colt = pn * 256; mode = 0; }
        else if (pn < 8) { base = GV; ldc = 1024; colt = (pn - 4) * 256; mode = 1; }
        else if (pn < 12) { base = Z; ldc = 1024; colt = (pn - 8) * 256; mode = 2; }
        else { base = XBC; ldc = 1536; colt = (pn - 12) * 256; mode = 3; }
        const int col0 = colt + wc * 32 + 8 * fq;
#pragma unroll
        for (int ai = 0; ai < 2; ++ai)
#pragma unroll
            for (int m = 0; m < 4; ++m) {
                const int row = row0 + ai * HALF + m * 16;
                bf16_t* rowp = base + (size_t)row * ldc + col0; float ssq = 0.f;
#pragma unroll
                for (int bj = 0; bj < 2; ++bj) {
                    f32x4 v0 = acc[ai][bj][m][0], v1 = acc[ai][bj][m][1];
                    if (mode <= 1) {
                        f32x2 a = {v0[0], v0[1]}, b = {v0[2], v0[3]}, c = {v1[0], v1[1]}, d = {v1[2], v1[3]};
                        gelu_pk4(a, b, c, d);
                        v0 = (f32x4){a.x, a.y, b.x, b.y}; v1 = (f32x4){c.x, c.y, d.x, d.y};
                        ssq += (v0[0] * v0[0] + v0[1] * v0[1]) + (v0[2] * v0[2] + v0[3] * v0[3]) + (v1[0] * v1[0] + v1[1] * v1[1]) + (v1[2] * v1[2] + v1[3] * v1[3]);
                    } else if (mode == 2) {
                        f32x2 a = {v0[0], v0[1]}, b = {v0[2], v0[3]}, c = {v1[0], v1[1]}, d = {v1[2], v1[3]};
                        silu_pk4(a, b, c, d);
                        v0 = (f32x4){a.x, a.y, b.x, b.y}; v1 = (f32x4){c.x, c.y, d.x, d.y};
                    }
                    u32x4 w; w.x = cvt_pk_bf16(v0[0], v0[1]); w.y = cvt_pk_bf16(v0[2], v0[3]); w.z = cvt_pk_bf16(v1[0], v1[1]); w.w = cvt_pk_bf16(v1[2], v1[3]);
                    *(u32x4*)(rowp + bj * HALF) = w;
                }
                if (mode == 1) { ssq += __shfl_xor(ssq, 16); ssq += __shfl_xor(ssq, 32); if (fq == 0) unsafeAtomicAdd(vss + row, ssq); }
            }
    }
};
}
namespace pg8 {
template <class Epi, class Sched, bool ALIGN_EPI = false, bool SP2 = false>
__device__ __forceinline__ void gemm_phase(PG8_LAS unsigned char* lds, const Gemm g, const Sched& S, const Epi& E) {
    const int tid = threadIdx.x, wid = __builtin_amdgcn_readfirstlane(tid >> 6), lane = tid & 63, wr = wid >> 2, wc = wid & 3, fr = lane & 15, fq = lane >> 4;
    const int K = g.K, nt = K / BK;
    unsigned voffA[2], voffB[2];
#pragma unroll
    for (int i = 0; i < 2; ++i) { int R, C; stage_rc(tid * 16 + i * 8192, R, C); const int Rb = Epi::PERM ? ((R & ~31) + perm32(R & 31)) : R;
        voffA[i] = (unsigned)(R * K + C) * 2u; voffB[i] = (unsigned)(Rb * K + C) * 2u; }
    const size_t kstep = (size_t)(BK * 2);
    const size_t hstep = (size_t)HALF * K * 2;
    const size_t tstep = 2 * hstep;
    const unsigned ldsw = (unsigned)wid * 1024u;
    const int aoff = lds_byte(wr * 64 + fr, fq * 8), boff = lds_byte(wc * 32 + fr, fq * 8);
#define PG8_SA(b, h) (((b) * 2 + (h)) * HTB)
#define PG8_SB(b, h) ((4 + (b) * 2 + (h)) * HTB)
#define PG8_STAGE(bufoff, gbase, voff) do { _Pragma("unroll") for (int _i = 0; _i < 2; ++_i) \
        __builtin_amdgcn_global_load_lds((const unsigned*)((const char*)(gbase) + (voff)[_i]), (PG8_LAS unsigned*)(lds + (bufoff) + ldsw + _i * 8192), 16, 0, 0); } while (0)
#define PG8_LDA(dst, b, h) do { _Pragma("unroll") for (int m = 0; m < 4; ++m) _Pragma("unroll") for (int k = 0; k < 2; ++k) dst[m][k] = *(const PG8_LAS bf16x8*)(lds + PG8_SA(b, h) + aoff + m * 2048 + k * 1024); } while (0)
#define PG8_LDB(dst, b, h) do { _Pragma("unroll") for (int n = 0; n < 2; ++n) _Pragma("unroll") for (int k = 0; k < 2; ++k) dst[n][k] = *(const PG8_LAS bf16x8*)(lds + PG8_SB(b, h) + boff + n * 2048 + k * 1024); } while (0)
#define PG8_MMA(ai, bj, At, Bt) do { __builtin_amdgcn_s_setprio(1); _Pragma("unroll") for (int k = 0; k < 2; ++k) _Pragma("unroll") for (int m = 0; m < 4; ++m) _Pragma("unroll") for (int n = 0; n < 2; ++n) \
        acc[ai][bj][m][n] = __builtin_amdgcn_mfma_f32_16x16x32_bf16(Bt[n][k], At[m][k], acc[ai][bj][m][n], 0, 0, 0); __builtin_amdgcn_s_setprio(0); } while (0)
#define PG8_WAIT_V(n) asm volatile("s_waitcnt vmcnt(" #n ")" ::: "memory")
#define PG8_WAIT_L(n) asm volatile("s_waitcnt lgkmcnt(" #n ")" ::: "memory")
#define PG8_BAR __builtin_amdgcn_s_barrier()
#define PG8_SCHED __builtin_amdgcn_sched_barrier(0)
    Unit cur, nxt; int ui = 0;
    if (!S.next(0, cur)) return;
    f32x4 acc[2][2][4][2];
#pragma unroll
    for (int a = 0; a < 2; ++a)
#pragma unroll
        for (int b = 0; b < 2; ++b)
#pragma unroll
            for (int m = 0; m < 4; ++m)
#pragma unroll
                for (int n = 0; n < 2; ++n) acc[a][b][m][n] = (f32x4){0.f, 0.f, 0.f, 0.f};
    bf16x8 At[4][2], B0[2][2], B1[2][2];
    const char* cA = (const char*)g.A + (size_t)cur.pm * tstep; const char* cB = (const char*)g.Bt + (size_t)cur.pn * tstep;
    S.a_ready(cur);
    if constexpr (SP2) {
        PG8_STAGE(PG8_SB(0, 0), cB, voffB); PG8_STAGE(PG8_SB(0, 1), cB + hstep, voffB); PG8_STAGE(PG8_SA(0, 0), cA, voffA); PG8_STAGE(PG8_SA(0, 1), cA + hstep, voffA);
        if (wr == 1) PG8_BAR;
        PG8_WAIT_V(2); PG8_BAR;
        PG8_STAGE(PG8_SB(1, 0), cB + kstep, voffB); PG8_STAGE(PG8_SA(1, 0), cA + kstep, voffA); PG8_STAGE(PG8_SB(1, 1), cB + hstep + kstep, voffB);
        PG8_WAIT_V(6); PG8_BAR;
    } else {
        PG8_STAGE(PG8_SB(0, 0), cB, voffB); PG8_STAGE(PG8_SA(0, 0), cA, voffA); PG8_STAGE(PG8_SB(0, 1), cB + hstep, voffB); PG8_STAGE(PG8_SA(0, 1), cA + hstep, voffA);
        if (wr == 1) PG8_BAR;
        PG8_WAIT_V(4); PG8_BAR;
        PG8_STAGE(PG8_SB(1, 0), cB + kstep, voffB); PG8_STAGE(PG8_SA(1, 0), cA + kstep, voffA); PG8_STAGE(PG8_SB(1, 1), cB + hstep + kstep, voffB);
        PG8_WAIT_V(6); PG8_BAR;
    }
    for (;;) {
        const bool has_next = S.next(ui + 1, nxt);
        const char* nA = has_next ? (const char*)g.A + (size_t)nxt.pm * tstep : cA; const char* nB = has_next ? (const char*)g.Bt + (size_t)nxt.pn * tstep : cB;
        for (int t = 0; t < nt; t += 2) {
            const bool last = (t == nt - 2);
            const char* a1 = cA + (size_t)(t + 1) * kstep;
            const char* a2 = last ? nA : cA + (size_t)(t + 2) * kstep; const char* b2 = last ? nB : cB + (size_t)(t + 2) * kstep;
            const char* a3 = a2 + kstep; const char* b3 = b2 + kstep;
            if (last && has_next) S.a_ready(nxt);
            if constexpr (SP2) {
            PG8_LDB(B0, 0, 0); PG8_LDB(B1, 0, 1); PG8_SCHED; PG8_LDA(At, 0, 0); PG8_STAGE(PG8_SA(1, 1), a1 + hstep, voffA);
            PG8_WAIT_V(8); PG8_WAIT_L(0); PG8_BAR; PG8_MMA(0, 0, At, B0); PG8_MMA(0, 1, At, B1); PG8_BAR; PG8_SCHED;
            PG8_LDA(At, 0, 1); PG8_STAGE(PG8_SB(0, 0), b2, voffB); PG8_STAGE(PG8_SB(0, 1), b2 + hstep, voffB); PG8_STAGE(PG8_SA(0, 0), a2, voffA);
            PG8_WAIT_V(8); PG8_WAIT_L(0); PG8_BAR; PG8_MMA(1, 0, At, B0); PG8_MMA(1, 1, At, B1); PG8_BAR; PG8_SCHED;
            PG8_LDB(B0, 1, 0); PG8_LDB(B1, 1, 1); PG8_SCHED; PG8_LDA(At, 1, 0); PG8_STAGE(PG8_SA(0, 1), a2 + hstep, voffA);
            PG8_WAIT_V(8); PG8_WAIT_L(0); PG8_BAR; PG8_MMA(0, 0, At, B0); PG8_MMA(0, 1, At, B1); PG8_BAR; PG8_SCHED;
            PG8_LDA(At, 1, 1); PG8_STAGE(PG8_SB(1, 0), b3, voffB); PG8_STAGE(PG8_SB(1, 1), b3 + hstep, voffB); PG8_STAGE(PG8_SA(1, 0), a3, voffA);
            PG8_WAIT_V(8); PG8_WAIT_L(0); PG8_BAR; PG8_MMA(1, 0, At, B0); PG8_MMA(1, 1, At, B1); PG8_BAR; PG8_SCHED;
            } else {
            PG8_LDB(B0, 0, 0); PG8_SCHED; PG8_LDA(At, 0, 0); PG8_STAGE(PG8_SA(1, 1), a1 + hstep, voffA);
            PG8_WAIT_L(8); PG8_BAR; PG8_WAIT_L(0); PG8_MMA(0, 0, At, B0); PG8_BAR; PG8_SCHED;
            PG8_LDB(B1, 0, 1); PG8_STAGE(PG8_SB(0, 0), b2, voffB);
            PG8_BAR; PG8_WAIT_L(0); PG8_MMA(0, 1, At, B1); PG8_BAR;
            PG8_LDA(At, 0, 1); PG8_STAGE(PG8_SA(0, 0), a2, voffA);
            PG8_BAR; PG8_WAIT_L(0); PG8_MMA(1, 0, At, B0); PG8_BAR; PG8_SCHED;
            PG8_STAGE(PG8_SB(0, 1), b2 + hstep, voffB);
            PG8_WAIT_V(6); PG8_BAR; PG8_MMA(1, 1, At, B1); PG8_BAR;
            PG8_LDB(B0, 1, 0); PG8_SCHED; PG8_LDA(At, 1, 0); PG8_STAGE(PG8_SA(0, 1), a2 + hstep, voffA);
            PG8_WAIT_L(8); PG8_BAR; PG8_WAIT_L(0); PG8_MMA(0, 0, At, B0); PG8_BAR; PG8_SCHED;
            PG8_LDB(B1, 1, 1); PG8_STAGE(PG8_SB(1, 0), b3, voffB);
            PG8_BAR; PG8_WAIT_L(0); PG8_MMA(0, 1, At, B1); PG8_BAR;
            PG8_LDA(At, 1, 1); PG8_STAGE(PG8_SA(1, 0), a3, voffA);
            PG8_BAR; PG8_WAIT_L(0); PG8_MMA(1, 0, At, B0); PG8_BAR; PG8_SCHED;
            PG8_STAGE(PG8_SB(1, 1), b3 + hstep, voffB);
            PG8_WAIT_V(6); PG8_BAR; PG8_MMA(1, 1, At, B1); PG8_BAR;
            }
        }
        if constexpr (ALIGN_EPI) { if (wr == 0) PG8_BAR; }
        if constexpr (!Epi::AFTER_DRAIN) { E(acc, cur, wr, wc, fr, fq); S.done(cur); }
        if (!has_next) break;
#pragma unroll
        for (int a = 0; a < 2; ++a)
#pragma unroll
            for (int b = 0; b < 2; ++b)
#pragma unroll
                for (int m = 0; m < 4; ++m)
#pragma unroll
                    for (int n = 0; n < 2; ++n) acc[a][b][m][n] = (f32x4){0.f, 0.f, 0.f, 0.f};
        cur = nxt; cA = nA; cB = nB; ++ui;
        if constexpr (ALIGN_EPI) { if (wr == 1) PG8_BAR; }
    }
    PG8_WAIT_V(0);
    if constexpr (!ALIGN_EPI) { if (wr == 0) PG8_BAR; }
    PG8_BAR;
    if constexpr (Epi::AFTER_DRAIN) { E.fused(acc, cur, wr, wc, fr, fq, lds, wid, lane); S.done(cur); }
#undef PG8_SA
#undef PG8_SB
#undef PG8_STAGE
#undef PG8_LDA
#undef PG8_LDB
#undef PG8_MMA
#undef PG8_WAIT_V
#undef PG8_WAIT_L
#undef PG8_BAR
#undef PG8_SCHED
}
}
#define LAS __attribute__((address_space(3)))
typedef unsigned short bf16;
typedef unsigned v4u __attribute__((ext_vector_type(4)));
typedef unsigned v2u __attribute__((ext_vector_type(2)));
typedef float f32x4 __attribute__((ext_vector_type(4)));
typedef short bf16x8 __attribute__((ext_vector_type(8)));

constexpr int M = 16384, SEQ = 8192, D = 2048, FF = 5504, NGU = 2 * FF, AW = 1024, NIN = 4608, NINF = 4624, XBCW = 1536;
constexpr float EPS = 1e-6f;
constexpr size_t MiB = 1u << 20;
constexpr size_t WS_VSS = 0;
constexpr size_t WS_WGU1 = 1 * MiB, WS_WD1 = 44 * MiB, WS_WGU2 = 66 * MiB, WS_WD2 = 109 * MiB, WS_WIN = 131 * MiB, WS_WOUT = 150 * MiB, WS_WSP = 158 * MiB;
constexpr size_t WS_HB = 159 * MiB;
constexpr size_t WS_GU = 159 * MiB, WS_GV = 191 * MiB, WS_Z = 223 * MiB, WS_XBC = 255 * MiB, WS_DTRAW = 303 * MiB, WS_DT = 304 * MiB, WS_ACS = 305 * MiB, WS_BM = 306 * MiB, WS_CM = 314 * MiB;
constexpr size_t WS_HF2 = 159 * MiB;
constexpr size_t WS_XN = 331 * MiB;
constexpr size_t WS_YCAT = 331 * MiB;
constexpr size_t WS_XS = 395 * MiB, WS_XDTT = 427 * MiB, WS_ST = 459 * MiB, WS_PREV = 491 * MiB, WS_END = 507 * MiB;
constexpr size_t WS_HF3 = 331 * MiB;
static_assert(WS_HB + (size_t)M * FF * 2 <= WS_XN, "HB");
static_assert(WS_CM + 8 * MiB <= WS_XN, "map");

constexpr int LDS_BYTES = 147456;

__device__ __forceinline__ float bflo(unsigned w) { return __uint_as_float(w << 16); }
__device__ __forceinline__ float bfhi(unsigned w) { return __uint_as_float(w & 0xffff0000u); }
__device__ __forceinline__ unsigned pk2(float lo, float hi) { return pg8::cvt_pk_bf16(lo, hi); }
__device__ __forceinline__ unsigned short f2bf1(float f) { return (unsigned short)(pk2(f, 0.f) & 0xffffu); }
__device__ __forceinline__ float wave_sum(float v) {
#pragma unroll
    for (int o = 1; o < 64; o <<= 1) v += __shfl_xor(v, o);
    return v;
}
__device__ __forceinline__ float silu1(float g) { return g * __builtin_amdgcn_rcpf(1.0f + __expf(-g)); }
#define MFMA16(a, b, c) __builtin_amdgcn_mfma_f32_16x16x32_bf16((a), (b), (c), 0, 0, 0)

__device__ __forceinline__ void transpose_item(const float* W, int ldn, int K, bf16* WT, int k0, int n0, int drow0, LAS unsigned* T, int lane) {
    constexpr int STR = 66;
    const float* wp = W + (size_t)k0 * ldn + n0 + lane;
#pragma unroll
    for (int b = 0; b < 4; ++b) {
        float t[32];
#pragma unroll
        for (int i = 0; i < 32; ++i) t[i] = __builtin_nontemporal_load(wp + (size_t)(32 * b + i) * ldn);
#pragma unroll
        for (int i = 0; i < 16; ++i) T[lane * STR + 16 * b + i] = pk2(t[2 * i], t[2 * i + 1]);
        asm volatile("" ::: "memory");
    }
    asm volatile("s_waitcnt lgkmcnt(0)" ::: "memory");
    const int c = lane & 15, r = lane >> 4;
#pragma unroll
    for (int j = 0; j < 16; ++j) { const int row = 4 * j + r;
        const v2u lo = *(const LAS v2u*)(T + row * STR + 4 * c), hi = *(const LAS v2u*)(T + row * STR + 4 * c + 2);
        v4u o; o.x = lo.x; o.y = lo.y; o.z = hi.x; o.w = hi.y;
        *(v4u*)(WT + (size_t)(drow0 + row) * K + k0 + 8 * c) = o; }
    asm volatile("s_waitcnt lgkmcnt(0)" ::: "memory");
}
__device__ __forceinline__ void transpose_seg(const float* W, int ldn, int K, int nblk, bf16* WT, int mode, int item, LAS unsigned* T, int lane) {
    const int kb = item / nblk, nb = item % nblk, n0 = 64 * nb;
    const int drow0 = mode == 0 ? n0 : (n0 + 128 * (n0 >> 7) + (mode == 2 ? 128 : 0));
    transpose_item(W, ldn, K, WT, 128 * kb, n0, drow0, T, lane);
}

template <int MODE, bool XR_BF, bool XD_BF>
__device__ __forceinline__ void row_pass(int gw, int NGW, int lane, const bf16* hsrc, const void* xres_, void* xdst_, float sc, const float* gpost, const float* gpre, bf16* xn) {
    struct RowIn { f32x4 xf[XR_BF ? 1 : 8]; v2u xb[XR_BF ? 8 : 1]; v2u hb[MODE >= 1 ? 8 : 1]; };
#define ROW_LOAD(MM, R) do { \
        if constexpr (XR_BF) { const v2u* xr_ = (const v2u*)((const bf16*)xres_ + (size_t)(MM) * D) + lane; _Pragma("unroll") for (int j = 0; j < 8; ++j) R.xb[j] = __builtin_nontemporal_load(xr_ + 64 * j); } \
        else { const f32x4* xr_ = (const f32x4*)((const float*)xres_ + (size_t)(MM) * D) + lane; _Pragma("unroll") for (int j = 0; j < 8; ++j) R.xf[j] = __builtin_nontemporal_load(xr_ + 64 * j); } \
        if constexpr (MODE >= 1) { const v2u* hr_ = (const v2u*)(hsrc + (size_t)(MM) * D) + lane; _Pragma("unroll") for (int j = 0; j < 8; ++j) R.hb[j] = __builtin_nontemporal_load(hr_ + 64 * j); } } while (0)
    f32x4 gp[MODE >= 1 ? 8 : 1], gq[MODE != 2 ? 8 : 1];
    if constexpr (MODE >= 1) {
#pragma unroll
        for (int j = 0; j < 8; ++j) gp[j] = ((const f32x4*)gpost)[64 * j + lane]; }
    if constexpr (MODE != 2) {
#pragma unroll
        for (int j = 0; j < 8; ++j) gq[j] = ((const f32x4*)gpre)[64 * j + lane]; }
    RowIn cur{}, nxt{};
    if (gw < M) ROW_LOAD(gw, cur);
    for (int m = gw; m < M; m += NGW) {
        if (m + NGW < M) ROW_LOAD(m + NGW, nxt);
        f32x4 xv[8];
#pragma unroll
        for (int j = 0; j < 8; ++j) { if constexpr (XR_BF) { const v2u w = cur.xb[j]; xv[j] = (f32x4){bflo(w.x), bfhi(w.x), bflo(w.y), bfhi(w.y)}; } else xv[j] = cur.xf[j]; }
        if constexpr (MODE >= 1) {
            f32x4 hv[8]; float ss = 0.f;
#pragma unroll
            for (int j = 0; j < 8; ++j) { const v2u hw = cur.hb[j]; hv[j] = (f32x4){bflo(hw.x), bfhi(hw.x), bflo(hw.y), bfhi(hw.y)}; ss += (hv[j].x * hv[j].x + hv[j].y * hv[j].y) + (hv[j].z * hv[j].z + hv[j].w * hv[j].w); }
            const float rs = sc * __frsqrt_rn(wave_sum(ss) * (1.0f / D) + EPS);
#pragma unroll
            for (int j = 0; j < 8; ++j) xv[j] = xv[j] + hv[j] * gp[j] * rs;
            if constexpr (XD_BF) { v2u* xo = (v2u*)((bf16*)xdst_ + (size_t)m * D) + lane;
#pragma unroll
                for (int j = 0; j < 8; ++j) { v2u w; w.x = pk2(xv[j].x, xv[j].y); w.y = pk2(xv[j].z, xv[j].w); __builtin_nontemporal_store(w, xo + 64 * j); } }
            else { f32x4* xo = (f32x4*)((float*)xdst_ + (size_t)m * D) + lane;
#pragma unroll
                for (int j = 0; j < 8; ++j) __builtin_nontemporal_store(xv[j], xo + 64 * j); }
        }
        if constexpr (MODE != 2) {
            float ss = 0.f;
#pragma unroll
            for (int j = 0; j < 8; ++j) ss += (xv[j].x * xv[j].x + xv[j].y * xv[j].y) + (xv[j].z * xv[j].z + xv[j].w * xv[j].w);
            const float rs = __frsqrt_rn(wave_sum(ss) * (1.0f / D) + EPS);
            v2u* o8 = (v2u*)(xn + (size_t)m * D) + lane;
#pragma unroll
            for (int j = 0; j < 8; ++j) { const f32x4 g = gq[j]; v2u w; w.x = pk2(xv[j].x * rs * g.x, xv[j].y * rs * g.y); w.y = pk2(xv[j].z * rs * g.z, xv[j].w * rs * g.w); o8[64 * j] = w; }
        }
        cur = nxt;
    }
#undef ROW_LOAD
}

#define XB_TMO      128
#define XB_XCNT(j)  (256  + 64 * (j))
#define XB_XSUB(j)  (1280 + 64 * (j))
#define XB_XGEN(j)  (2304 + 64 * (j))
#define XB_TOP      3328
#define XB_TOPGEN   3392
#define XCD_BAR_WORDS 3456
#define XB_SPIN_CAP (1u << 18)

__device__ __forceinline__ unsigned xb_ld(unsigned* p)              { return __hip_atomic_load(p, __ATOMIC_RELAXED, __HIP_MEMORY_SCOPE_AGENT); }
__device__ __forceinline__ unsigned xb_add(unsigned* p, unsigned v) { return __hip_atomic_fetch_add(p, v, __ATOMIC_RELAXED, __HIP_MEMORY_SCOPE_AGENT); }
__device__ __forceinline__ unsigned xb_xcc_id() { return (unsigned)__builtin_amdgcn_s_getreg((3 << 11) | 20) & 0xFu; }
#define XB_SPIN(cond, bar) do { unsigned _sp = 0; while (cond) { __builtin_amdgcn_s_sleep(1); \
    if ((++_sp & 255u) == 0u) { if (xb_ld(&(bar)[XB_TMO])) break; if (_sp > XB_SPIN_CAP) { atomicAdd(&(bar)[XB_TMO], 1u); break; } } } } while (0)

struct XcdBarrier {
    unsigned* bar; unsigned x;
    volatile LAS unsigned* st;
};

__device__ __forceinline__ XcdBarrier xcd_barrier_post(unsigned* bar, volatile LAS unsigned* st) {
    XcdBarrier b; b.bar = bar; b.x = xb_xcc_id(); b.st = st;
    if (threadIdx.x == 0) (void)xb_add(&bar[XB_XCNT(b.x)], 1u);
    return b;
}
__device__ __forceinline__ void xcd_barrier_complete(unsigned* bar, unsigned x, unsigned& nloc, unsigned& nx) {
    const unsigned G = gridDim.x * gridDim.y * gridDim.z;
    unsigned sum, cnt, mine, sp = 0u;
    for (;;) {
        sum = 0u; cnt = 0u; mine = 0u;
#pragma unroll
        for (unsigned j = 0; j < 16; ++j) { const unsigned c = xb_ld(&bar[XB_XCNT(j)]); sum += c; cnt += (c > 0u) ? 1u : 0u; mine = (j == x) ? c : mine; }
        if (sum == G) break;
        __builtin_amdgcn_s_sleep(1);
        if ((++sp & 255u) == 0u) { if (xb_ld(&bar[XB_TMO])) break; if (sp > XB_SPIN_CAP) { atomicAdd(&bar[XB_TMO], 1u); break; } }
    }
    nloc = mine > 0u ? mine : 1u; nx = cnt > 0u ? cnt : 1u;
}

__device__ __forceinline__ void xcd_barrier(const XcdBarrier& b) {
    asm volatile("s_waitcnt vmcnt(0)" ::: "memory");
    __syncthreads();
    if (threadIdx.x == 0) {
        unsigned* bar = b.bar;
        __builtin_amdgcn_s_waitcnt(0);
        unsigned nloc = b.st[0], nx = b.st[1];
        if (nloc == 0u) { xcd_barrier_complete(bar, b.x, nloc, nx); b.st[0] = nloc; b.st[1] = nx; }
        const unsigned old = xb_add(&bar[XB_XSUB(b.x)], 1u);
        const unsigned gen = old / nloc;
        if (old + 1u == (gen + 1u) * nloc) {
            __builtin_amdgcn_fence(__ATOMIC_RELEASE, "agent");
            asm volatile("s_waitcnt vmcnt(0)" ::: "memory");
            const unsigned og = xb_add(&bar[XB_TOP], 1u);
            const unsigned tg = og / nx;
            if (og + 1u == (tg + 1u) * nx) xb_add(&bar[XB_TOPGEN], 1u);
            else XB_SPIN(xb_ld(&bar[XB_TOPGEN]) == tg, bar);
            __builtin_amdgcn_fence(__ATOMIC_ACQUIRE, "agent");
            xb_add(&bar[XB_XGEN(b.x)], 1u);
            asm volatile("s_waitcnt vmcnt(0)" ::: "memory");
        } else {
            XB_SPIN(xb_ld(&bar[XB_XGEN(b.x)]) == gen, bar);
            __builtin_amdgcn_fence(__ATOMIC_ACQUIRE, "agent");
            asm volatile("s_waitcnt vmcnt(0)" ::: "memory");
        }
    }
    __syncthreads();
}

constexpr size_t WS_BAR = 512 * 1024;
struct Args { const float* in[24]; float* out; unsigned char* ws; };

__global__ void __launch_bounds__(512, 2) fwd_mega(Args a) {
    extern __shared__ __attribute__((aligned(16))) unsigned char lds_raw[];
    LAS unsigned char* lds = (LAS unsigned char*)lds_raw;
    const int wave = __builtin_amdgcn_readfirstlane((int)threadIdx.x >> 6);
    const int G = gridDim.x, bx = blockIdx.x;
    const int gw = bx * 8 + wave, NGW = G * 8, NT = G * 512;

    unsigned char* ws = a.ws;
    float* const out = a.out;
    float* const VSS = (float*)(ws + WS_VSS);
    bf16* const WGU1 = (bf16*)(ws + WS_WGU1); bf16* const WD1 = (bf16*)(ws + WS_WD1); bf16* const WGU2 = (bf16*)(ws + WS_WGU2); bf16* const WD2 = (bf16*)(ws + WS_WD2);
    bf16* const WIN = (bf16*)(ws + WS_WIN); bf16* const WOUT = (bf16*)(ws + WS_WOUT); bf16* const WSP = (bf16*)(ws + WS_WSP);
    bf16* const HB = (bf16*)(ws + WS_HB); bf16* const XN = (bf16*)(ws + WS_XN); bf16* const YCAT = (bf16*)(ws + WS_YCAT);
    bf16* const GU = (bf16*)(ws + WS_GU); bf16* const GV = (bf16*)(ws + WS_GV); bf16* const ZB = (bf16*)(ws + WS_Z); bf16* const XBC = (bf16*)(ws + WS_XBC);
    float* const DTRAW = (float*)(ws + WS_DTRAW); float* const DT = (float*)(ws + WS_DT); float* const ACS = (float*)(ws + WS_ACS);
    bf16* const BMm = (bf16*)(ws + WS_BM); bf16* const CMm = (bf16*)(ws + WS_CM); bf16* const XS = (bf16*)(ws + WS_XS); bf16* const XDTT = (bf16*)(ws + WS_XDTT);
    float* const ST = (float*)(ws + WS_ST); bf16* const PREV = (bf16*)(ws + WS_PREV);
    bf16* const X1 = (bf16*)out; bf16* const X2 = (bf16*)(ws + WS_XS); bf16* const HF1 = (bf16*)(ws + WS_XN); bf16* const HF2 = (bf16*)(ws + WS_HF2); bf16* const HF3 = (bf16*)(ws + WS_XN);

    unsigned* const barw = (unsigned*)(ws + WS_BAR);
    volatile LAS unsigned* xst = (volatile LAS unsigned*)(lds + LDS_BYTES - 64);
    if (threadIdx.x < 4) xst[threadIdx.x] = 0u;
    __syncthreads();
    const XcdBarrier xb = xcd_barrier_post(barw, xst);
#define GRID_SYNC() xcd_barrier(xb)
    constexpr int I_GU = (D / 128) * (FF / 64), I_IN = (D / 128) * (NIN / 64), I_OUT = (D / 128) * (D / 64), I_DN = (FF / 128) * (D / 64);
    constexpr int NITEMS = 4 * I_GU + I_IN + I_OUT + 2 * I_DN;
#define CONVERT_ONE(IT) do { int r = (IT); \
            if (r < I_GU) { transpose_seg(a.in[3], FF, D, FF / 64, WGU1, 1, r, scr, lane); break; } r -= I_GU; \
            if (r < I_GU) { transpose_seg(a.in[4], FF, D, FF / 64, WGU1, 2, r, scr, lane); break; } r -= I_GU; \
            if (r < I_DN) { transpose_seg(a.in[5], D, FF, D / 64, WD1, 0, r, scr, lane); break; } r -= I_DN; \
            if (r < I_IN) { transpose_seg(a.in[8], NINF, D, NIN / 64, WIN, 0, r, scr, lane); break; } r -= I_IN; \
            if (r < I_OUT) { transpose_seg(a.in[18], D, D, D / 64, WOUT, 0, r, scr, lane); break; } r -= I_OUT; \
            if (r < I_GU) { transpose_seg(a.in[21], FF, D, FF / 64, WGU2, 1, r, scr, lane); break; } r -= I_GU; \
            if (r < I_GU) { transpose_seg(a.in[22], FF, D, FF / 64, WGU2, 2, r, scr, lane); break; } r -= I_GU; \
            transpose_seg(a.in[23], D, FF, D / 64, WD2, 0, r, scr, lane); } while (0)
#define CONVERT_ITEMS(LO, HI) do { LAS unsigned* scr = (LAS unsigned*)(lds + wave * 16896); \
        for (int it = (LO) + gw; it < (HI); it += NGW) CONVERT_ONE(it); } while (0)
#define CONVERT_STEAL(CNT, LO, HI) do { LAS unsigned* scr = (LAS unsigned*)(lds + wave * 16896); \
        for (;;) { int it = 0; if (lane == 0) it = (int)__hip_atomic_fetch_add((CNT), 1u, __ATOMIC_RELAXED, __HIP_MEMORY_SCOPE_AGENT); \
            it = __builtin_amdgcn_readfirstlane(it) + (LO); if (it >= (HI)) break; CONVERT_ONE(it); } } while (0)
    constexpr int IT_P1B = 2 * I_GU, IT_P3T = 2 * I_GU + I_DN + I_IN + I_OUT;
    {
        int tid = threadIdx.x; asm volatile("" : "+v"(tid)); const int lane = tid & 63, fr = lane & 15, fq = lane >> 4, gt = bx * 512 + tid; (void)fr; (void)fq; (void)gt;
        CONVERT_ITEMS(0, 2 * I_GU);
        for (int i = gt; i < 16 * D; i += NT) { const int j = i / D, k = i % D; WIN[(size_t)(NIN + j) * D + k] = f2bf1(a.in[8][(size_t)k * NINF + NIN + j]); }
        for (int i = gt; i < 8 * 128 * 128; i += NT) { const int t = (i >> 7) & 127, s = i & 127; WSP[i] = s <= t ? f2bf1(a.in[10][i]) : (unsigned short)0; }
        for (int i = gt; i < M; i += NT) VSS[i] = 0.f;
        row_pass<0, false, false>(gw, NGW, lane, nullptr, a.in[0], nullptr, 0.f, nullptr, a.in[1], XN);
    }
    GRID_SYNC();
    { pg8::Gemm g{XN, WGU1, M, NGU, D}; pg8::StaticOrder S; S.init(M, NGU, G, bx); pg8::EpiSwiGLU E{HB, FF};
      pg8::gemm_phase<pg8::EpiSwiGLU, pg8::StaticOrder, true, true>(lds, g, S, E); }
    {
        int tid = threadIdx.x; asm volatile("" : "+v"(tid)); const int lane = tid & 63, fr = lane & 15, fq = lane >> 4, gt = bx * 512 + tid; (void)fr; (void)fq; (void)gt;
        CONVERT_STEAL(barw + 3584, IT_P1B, IT_P3T);
    }
    GRID_SYNC();
    { pg8::Gemm g{HB, WD1, M, D, FF}; pg8::StaticOrder S; S.init(M, D, G, bx); pg8::EpiBf16P E{HF1, D};
      pg8::gemm_phase<pg8::EpiBf16P, pg8::StaticOrder, true, true>(lds, g, S, E); }
    GRID_SYNC();
    {
        int tid = threadIdx.x; asm volatile("" : "+v"(tid)); const int lane = tid & 63, fr = lane & 15, fq = lane >> 4, gt = bx * 512 + tid; (void)fr; (void)fq; (void)gt;
        row_pass<1, false, true>(gw, NGW, lane, HF1, a.in[0], X1, 0.5f, a.in[2], a.in[6], XN);
    }
    GRID_SYNC();
    { pg8::Gemm g{XN, WIN, M, NIN, D}; pg8::StaticOrder S; S.init(M, NIN, G, bx); pg8::EpiInProj E{GU, GV, ZB, XBC, VSS};
      pg8::gemm_phase<pg8::EpiInProj, pg8::StaticOrder, true, true>(lds, g, S, E); }
    {
        int tid = threadIdx.x; asm volatile("" : "+v"(tid)); const int lane = tid & 63;
        CONVERT_STEAL(barw + 3648, IT_P3T, NITEMS);
    }
    {
        int tid = threadIdx.x; asm volatile("" : "+v"(tid)); const int lane = tid & 63, fr = lane & 15, fq = lane >> 4, gt = bx * 512 + tid; (void)fr; (void)fq; (void)gt;
    for (int it = gw; it < M / 16; it += NGW) {
        const int r0 = it * 16; f32x4 acc = {0.f, 0.f, 0.f, 0.f};
        const bf16* wp = WIN + (size_t)(NIN + fr) * D + fq * 8; const bf16* xp = XN + (size_t)(r0 + fr) * D + fq * 8;
#pragma unroll 8
        for (int ks = 0; ks < D / 32; ++ks) { const bf16x8 wa = *(const bf16x8*)(wp + 32 * ks), xb = *(const bf16x8*)(xp + 32 * ks); acc = MFMA16(wa, xb, acc); }
        *(f32x4*)(DTRAW + (size_t)(r0 + fr) * 16 + 4 * fq) = acc;
    }
    }
    GRID_SYNC();
    {
        int tid = threadIdx.x; asm volatile("" : "+v"(tid)); const int lane = tid & 63, fr = lane & 15, fq = lane >> 4, gt = bx * 512 + tid; (void)fr; (void)fq; (void)gt;
        const float* cw = a.in[12]; const float* cb = a.in[13];
        for (int it = gt; it < (M / 32) * (XBCW / 8); it += NT) {
            const int rb = it / (XBCW / 8), c8 = it % (XBCW / 8), ch = c8 * 8, r0 = rb * 32, t0 = r0 & (SEQ - 1);
            const f32x4 b0 = *(const f32x4*)(cb + ch), b1 = *(const f32x4*)(cb + ch + 4);
            f32x4 w0[4], w1[4];
#pragma unroll
            for (int k = 0; k < 4; ++k) { w0[k] = *(const f32x4*)(cw + k * XBCW + ch); w1[k] = *(const f32x4*)(cw + k * XBCW + ch + 4); }
            const bf16* xp = XBC + (size_t)r0 * XBCW + ch;
            v4u h3 = {0u, 0u, 0u, 0u}, h2 = h3, h1 = h3;
            if (t0 != 0) { h3 = *(const v4u*)(xp - 3 * XBCW); h2 = *(const v4u*)(xp - 2 * XBCW); h1 = *(const v4u*)(xp - XBCW); }
            float p3[8] = {bflo(h3.x), bfhi(h3.x), bflo(h3.y), bfhi(h3.y), bflo(h3.z), bfhi(h3.z), bflo(h3.w), bfhi(h3.w)};
            float p2[8] = {bflo(h2.x), bfhi(h2.x), bflo(h2.y), bfhi(h2.y), bflo(h2.z), bfhi(h2.z), bflo(h2.w), bfhi(h2.w)};
            float p1[8] = {bflo(h1.x), bfhi(h1.x), bflo(h1.y), bfhi(h1.y), bflo(h1.z), bfhi(h1.z), bflo(h1.w), bfhi(h1.w)};
            bf16* dst = ch < 1024 ? XS + (size_t)r0 * 1024 + ch : (ch < 1280 ? BMm + (size_t)r0 * 256 + (ch - 1024) : CMm + (size_t)r0 * 256 + (ch - 1280));
            const int dld = ch < 1024 ? 1024 : 256;
#pragma unroll 1
            for (int q = 0; q < 4; ++q) {
                v4u xr[8];
#pragma unroll
                for (int j = 0; j < 8; ++j) xr[j] = __builtin_nontemporal_load((const v4u*)(xp + (size_t)(8 * q + j) * XBCW));
#pragma unroll
                for (int j = 0; j < 8; ++j) {
                    const float c0[8] = {bflo(xr[j].x), bfhi(xr[j].x), bflo(xr[j].y), bfhi(xr[j].y), bflo(xr[j].z), bfhi(xr[j].z), bflo(xr[j].w), bfhi(xr[j].w)};
                    float y[8];
                    y[0] = b0.x + w0[0].x * p3[0] + w0[1].x * p2[0] + w0[2].x * p1[0] + w0[3].x * c0[0];
                    y[1] = b0.y + w0[0].y * p3[1] + w0[1].y * p2[1] + w0[2].y * p1[1] + w0[3].y * c0[1];
                    y[2] = b0.z + w0[0].z * p3[2] + w0[1].z * p2[2] + w0[2].z * p1[2] + w0[3].z * c0[2];
                    y[3] = b0.w + w0[0].w * p3[3] + w0[1].w * p2[3] + w0[2].w * p1[3] + w0[3].w * c0[3];
                    y[4] = b1.x + w1[0].x * p3[4] + w1[1].x * p2[4] + w1[2].x * p1[4] + w1[3].x * c0[4];
                    y[5] = b1.y + w1[0].y * p3[5] + w1[1].y * p2[5] + w1[2].y * p1[5] + w1[3].y * c0[5];
                    y[6] = b1.z + w1[0].z * p3[6] + w1[1].z * p2[6] + w1[2].z * p1[6] + w1[3].z * c0[6];
                    y[7] = b1.w + w1[0].w * p3[7] + w1[1].w * p2[7] + w1[2].w * p1[7] + w1[3].w * c0[7];
                    pg8::f32x2 sa = {y[0], y[1]}, sb = {y[2], y[3]}, sc = {y[4], y[5]}, sd = {y[6], y[7]};
                    pg8::silu_pk4(sa, sb, sc, sd);
                    v4u o; o.x = pk2(sa.x, sa.y); o.y = pk2(sb.x, sb.y); o.z = pk2(sc.x, sc.y); o.w = pk2(sd.x, sd.y);
                    *(v4u*)(dst + (size_t)(8 * q + j) * dld) = o;
#pragma unroll
                    for (int e = 0; e < 8; ++e) { p3[e] = p2[e]; p2[e] = p1[e]; p1[e] = c0[e]; }
                }
            }
        }
        for (int i = gt; i < M * 16; i += NT) { const float v = DTRAW[i] + a.in[14][i & 15]; DT[i] = fmaxf(v, 0.f) + log1pf(__expf(-fabsf(v))); }
        LAS unsigned short* vnT = (LAS unsigned short*)lds;
        LAS float* rsv = (LAS float*)(lds + 128 * 136 * 2);
        struct SguIn { v4u raw[4]; float vs[4]; f32x4 g0, g1; bf16x8 wbv[4]; v2u guv[8]; float bsv; };
        const int dc = tid & 15;
#define SGU_LOAD(U, X) do { const int hh_ = (U) & 7, rb_ = ((U) >> 3) * 128; \
            _Pragma("unroll") for (int i = 0; i < 4; ++i) { const int s_ = (tid + 512 * i) >> 4; X.raw[i] = __builtin_nontemporal_load((const v4u*)(GV + (size_t)(rb_ + s_) * AW + hh_ * 128 + 8 * dc)); X.vs[i] = VSS[rb_ + s_]; } \
            X.g0 = *(const f32x4*)(a.in[9] + hh_ * 128 + 8 * dc); X.g1 = *(const f32x4*)(a.in[9] + hh_ * 128 + 8 * dc + 4); \
            const bf16* wsp_ = WSP + (size_t)hh_ * 16384 + (16 * wave + fr) * 128 + 8 * fq; \
            _Pragma("unroll") for (int ks = 0; ks < 4; ++ks) X.wbv[ks] = *(const bf16x8*)(wsp_ + 32 * ks); \
            X.bsv = a.in[11][hh_ * 128 + 16 * wave + fr]; \
            _Pragma("unroll") for (int df = 0; df < 8; ++df) X.guv[df] = __builtin_nontemporal_load((const v2u*)(GU + (size_t)(rb_ + 16 * wave + fr) * AW + hh_ * 128 + 16 * df + 4 * fq)); } while (0)
        SguIn cur{}, nxt{};
        if (bx < 1024) SGU_LOAD(bx, cur);
        for (int u = bx; u < 1024; u += G) {
            const int hh = u & 7, rowbase = (u >> 3) * 128;
            const int row = rowbase + 16 * wave + fr;
#pragma unroll
            for (int i = 0; i < 4; ++i) {
                const int s = (tid + 512 * i) >> 4;
                const float rs = __frsqrt_rn(cur.vs[i] * (1.0f / AW) + EPS);
                LAS unsigned short* dstp = vnT + (8 * dc) * 136 + (s ^ (8 * (dc & 7)));
                dstp[0 * 136] = f2bf1(bflo(cur.raw[i].x) * rs * cur.g0.x); dstp[1 * 136] = f2bf1(bfhi(cur.raw[i].x) * rs * cur.g0.y);
                dstp[2 * 136] = f2bf1(bflo(cur.raw[i].y) * rs * cur.g0.z); dstp[3 * 136] = f2bf1(bfhi(cur.raw[i].y) * rs * cur.g0.w);
                dstp[4 * 136] = f2bf1(bflo(cur.raw[i].z) * rs * cur.g1.x); dstp[5 * 136] = f2bf1(bfhi(cur.raw[i].z) * rs * cur.g1.y);
                dstp[6 * 136] = f2bf1(bflo(cur.raw[i].w) * rs * cur.g1.z); dstp[7 * 136] = f2bf1(bfhi(cur.raw[i].w) * rs * cur.g1.w);
            }
            __syncthreads();
            if (u + G < 1024) SGU_LOAD(u + G, nxt);
            f32x4 acc[8];
#pragma unroll
            for (int df = 0; df < 8; ++df) acc[df] = (f32x4){0.f, 0.f, 0.f, 0.f};
            const int kmax = (wave >> 1) + 1;
#pragma unroll
            for (int ks = 0; ks < 4; ++ks) {
                if (ks < kmax) {
#pragma unroll
                    for (int df = 0; df < 8; ++df) { const bf16x8 va = *(const LAS bf16x8*)(vnT + (16 * df + fr) * 136 + ((32 * ks + 8 * fq) ^ (8 * ((2 * df + (fr >> 3)) & 7)))); acc[df] = MFMA16(va, cur.wbv[ks], acc[df]); }
                }
            }
#pragma unroll
            for (int df = 0; df < 8; ++df) {
                const int col = hh * 128 + 16 * df + 4 * fq;
                v2u o; o.x = pk2(bflo(cur.guv[df].x) * (acc[df][0] + cur.bsv), bfhi(cur.guv[df].x) * (acc[df][1] + cur.bsv)); o.y = pk2(bflo(cur.guv[df].y) * (acc[df][2] + cur.bsv), bfhi(cur.guv[df].y) * (acc[df][3] + cur.bsv));
                *(v2u*)(YCAT + (size_t)row * D + col) = o;
            }
            __syncthreads();
            cur = nxt;
        }
#undef SGU_LOAD
    }
    GRID_SYNC();
    {
        int tid = threadIdx.x; asm volatile("" : "+v"(tid)); const int lane = tid & 63, fr = lane & 15, fq = lane >> 4, gt = bx * 512 + tid; (void)fr; (void)fq; (void)gt;
        LAS float* acsL = (LAS float*)lds;
        LAS float* dtL = (LAS float*)(lds + 1024);
        LAS float* wtot = (LAS float*)(lds + 2048);
        LAS unsigned short* xT = (LAS unsigned short*)(lds + 4096);
        LAS unsigned short* bT = (LAS unsigned short*)(lds + 4096 + 64 * 264 * 2);
        struct P4In { float dtv; v4u rawx[4]; v4u rawb[8]; };
#define P4_LOAD(U, X) do { const int h_ = (U) & 15, rc_ = ((U) >> 4) * 256, g_ = h_ >> 3; \
            X.dtv = tid < 256 ? DT[(size_t)(rc_ + tid) * 16 + h_] : 0.f; \
            _Pragma("unroll") for (int i = 0; i < 4; ++i) { const int q = tid + 512 * i; X.rawx[i] = *(const v4u*)(XS + (size_t)(rc_ + (q >> 3)) * 1024 + h_ * 64 + 8 * (q & 7)); } \
            _Pragma("unroll") for (int i = 0; i < 8; ++i) { const int q = tid + 512 * i; X.rawb[i] = *(const v4u*)(BMm + (size_t)(rc_ + (q >> 4)) * 256 + g_ * 128 + 8 * (q & 15)); } } while (0)
        P4In cur{}, nxt{};
        if (bx < 1024) P4_LOAD(bx, cur);
        for (int u = bx; u < 1024; u += G) {
            const int h = u & 15, bc = u >> 4, g = h >> 3, rowc = bc * 256;
            const float ah = -__expf(a.in[15][h]);
            float v = 0.f; const float dtv = cur.dtv;
            if (tid < 256) {
                v = dtv * ah;
#pragma unroll
                for (int o = 1; o < 64; o <<= 1) { const float t = __shfl_up(v, o); if (lane >= o) v += t; }
                if (lane == 63) wtot[wave] = v;
            }
            __syncthreads();
            if (tid < 256) {
                float add = 0.f;
                for (int w = 0; w < 4; ++w) if (w < wave) add += wtot[w];
                v += add; acsL[tid] = v; dtL[tid] = dtv; ACS[(size_t)(rowc + tid) * 16 + h] = v;
            }
            __syncthreads();
            const float alast = acsL[255];
#pragma unroll
            for (int i = 0; i < 4; ++i) {
                const int q = tid + 512 * i, l = q >> 3, pc = q & 7;
                const v4u raw = cur.rawx[i];
                const float d = dtL[l];
                LAS unsigned short* dstp = xT + (8 * pc) * 264 + (l ^ (8 * pc));
                dstp[0 * 264] = f2bf1(bflo(raw.x) * d); dstp[1 * 264] = f2bf1(bfhi(raw.x) * d); dstp[2 * 264] = f2bf1(bflo(raw.y) * d); dstp[3 * 264] = f2bf1(bfhi(raw.y) * d);
                dstp[4 * 264] = f2bf1(bflo(raw.z) * d); dstp[5 * 264] = f2bf1(bfhi(raw.z) * d); dstp[6 * 264] = f2bf1(bflo(raw.w) * d); dstp[7 * 264] = f2bf1(bfhi(raw.w) * d);
            }
#pragma unroll
            for (int i = 0; i < 8; ++i) {
                const int q = tid + 512 * i, l = q >> 4, nc = q & 15;
                const v4u raw = cur.rawb[i];
                const float d = __expf(alast - acsL[l]);
                LAS unsigned short* dstp = bT + (8 * nc) * 264 + (l ^ (8 * (nc & 7)));
                dstp[0 * 264] = f2bf1(bflo(raw.x) * d); dstp[1 * 264] = f2bf1(bfhi(raw.x) * d); dstp[2 * 264] = f2bf1(bflo(raw.y) * d); dstp[3 * 264] = f2bf1(bfhi(raw.y) * d);
                dstp[4 * 264] = f2bf1(bflo(raw.z) * d); dstp[5 * 264] = f2bf1(bfhi(raw.z) * d); dstp[6 * 264] = f2bf1(bflo(raw.w) * d); dstp[7 * 264] = f2bf1(bfhi(raw.w) * d);
            }
            __syncthreads();
            if (u + G < 1024) P4_LOAD(u + G, nxt);
#pragma unroll
            for (int i = 0; i < 4; ++i) {
                const int q = tid + 512 * i, p = q >> 5, lc = q & 31;
                *(v4u*)(XDTT + (size_t)u * 16384 + p * 256 + 8 * lc) = *(const LAS v4u*)(xT + p * 264 + 8 * (lc ^ ((p >> 3) & 7)));
            }
            f32x4 acc[4];
#pragma unroll
            for (int pf = 0; pf < 4; ++pf) acc[pf] = (f32x4){0.f, 0.f, 0.f, 0.f};
#pragma unroll
            for (int ks = 0; ks < 8; ++ks) {
                const bf16x8 ba = *(const LAS bf16x8*)(bT + (16 * wave + fr) * 264 + ((32 * ks + 8 * fq) ^ (8 * ((2 * wave + (fr >> 3)) & 7))));
#pragma unroll
                for (int pf = 0; pf < 4; ++pf) { const bf16x8 xb = *(const LAS bf16x8*)(xT + (16 * pf + fr) * 264 + ((32 * ks + 8 * fq) ^ (8 * ((2 * pf + (fr >> 3)) & 7)))); acc[pf] = MFMA16(ba, xb, acc[pf]); }
            }
#pragma unroll
            for (int pf = 0; pf < 4; ++pf) *(f32x4*)(ST + (size_t)u * 8192 + (16 * pf + fr) * 128 + 16 * wave + 4 * fq) = acc[pf];
            __syncthreads();
            cur = nxt;
        }
#undef P4_LOAD
    }
    GRID_SYNC();
    {
        int tid = threadIdx.x; asm volatile("" : "+v"(tid)); const int lane = tid & 63, fr = lane & 15, fq = lane >> 4, gt = bx * 512 + tid; (void)fr; (void)fq; (void)gt;
    for (int vi = gt; vi < 131072; vi += NT) {
        const int e2 = vi * 2, n = e2 & 127, p = (e2 >> 7) & 63, h = (e2 >> 13) & 15, b = e2 >> 17;
        typedef float f32x2s __attribute__((ext_vector_type(2)));
        f32x2s carry = {0.f, 0.f};
        const size_t base = (size_t)(b * 32 * 16 + h) * 8192 + p * 128 + n;
#pragma unroll 1
        for (int c0 = 0; c0 < 32; c0 += 8) {
            f32x2s st[8]; float dc[8];
#pragma unroll
            for (int j = 0; j < 8; ++j) { st[j] = __builtin_nontemporal_load((const f32x2s*)(ST + base + (size_t)(c0 + j) * 131072)); dc[j] = ACS[(size_t)(b * SEQ + (c0 + j) * 256 + 255) * 16 + h]; }
#pragma unroll
            for (int j = 0; j < 8; ++j) { *(unsigned*)(PREV + base + (size_t)(c0 + j) * 131072) = pk2(carry.x, carry.y); carry = carry * __expf(dc[j]) + st[j]; }
        }
    }
    }
    GRID_SYNC();
    {
        int tid = threadIdx.x; asm volatile("" : "+v"(tid)); const int lane = tid & 63, fr = lane & 15, fq = lane >> 4, gt = bx * 512 + tid; (void)fr; (void)fq; (void)gt;
        LAS float* CB = (LAS float*)lds;
        LAS float* acsL = (LAS float*)(lds + 64 * 260 * 4);
        LAS float* ssL = (LAS float*)(lds + 64 * 260 * 4 + 8192);
        for (int uu = bx, rnd = 0; uu < 512; uu += G, ++rnd) {
            const int u = (rnd & 1) ? ((uu & ~3) | (3 - (uu & 3))) : uu;
            const int lb = u & 3, g = (u >> 2) & 1, bc = u >> 3, rowc = bc * 256, l0 = lb * 64, S = l0 + 64;
            for (int sf = wave; sf < S / 16; sf += 8) {
                f32x4 cacc[4];
#pragma unroll
                for (int lf = 0; lf < 4; ++lf) cacc[lf] = (f32x4){0.f, 0.f, 0.f, 0.f};
#pragma unroll
                for (int ks = 0; ks < 4; ++ks) {
                    const bf16x8 ba = *(const bf16x8*)(BMm + (size_t)(rowc + 16 * sf + fr) * 256 + g * 128 + 32 * ks + 8 * fq);
#pragma unroll
                    for (int lf = 0; lf < 4; ++lf) { const bf16x8 cbv = *(const bf16x8*)(CMm + (size_t)(rowc + l0 + 16 * lf + fr) * 256 + g * 128 + 32 * ks + 8 * fq); cacc[lf] = MFMA16(ba, cbv, cacc[lf]); }
                }
#pragma unroll
                for (int lf = 0; lf < 4; ++lf) *(LAS f32x4*)(CB + (16 * lf + fr) * 260 + 16 * sf + 4 * fq) = cacc[lf];
            }
#pragma unroll
            for (int i = 0; i < 4; ++i) { const int q = tid + 512 * i, hh = q >> 8, l = q & 255; acsL[q] = ACS[(size_t)(rowc + l) * 16 + g * 8 + hh]; }
            __syncthreads();
            const int hh = wave, h = g * 8 + hh; const size_t uh = (size_t)(bc * 16 + h);
            f32x4 acc[4][4];
#pragma unroll
            for (int pf = 0; pf < 4; ++pf)
#pragma unroll
                for (int lf = 0; lf < 4; ++lf) acc[pf][lf] = (f32x4){0.f, 0.f, 0.f, 0.f};
#pragma unroll
            for (int ks = 0; ks < 4; ++ks) {
                bf16x8 pa[4];
#pragma unroll
                for (int pf = 0; pf < 4; ++pf) pa[pf] = __builtin_nontemporal_load((const bf16x8*)(PREV + uh * 8192 + (16 * pf + fr) * 128 + 32 * ks + 8 * fq));
#pragma unroll
                for (int lf = 0; lf < 4; ++lf) { const bf16x8 cbv = *(const bf16x8*)(CMm + (size_t)(rowc + l0 + 16 * lf + fr) * 256 + g * 128 + 32 * ks + 8 * fq);
#pragma unroll
                    for (int pf = 0; pf < 4; ++pf) acc[pf][lf] = MFMA16(pa[pf], cbv, acc[pf][lf]); }
            }
            float al[4];
#pragma unroll
            for (int lf = 0; lf < 4; ++lf) { al[lf] = acsL[hh * 256 + l0 + 16 * lf + fr]; const float e = __expf(al[lf]);
#pragma unroll
                for (int pf = 0; pf < 4; ++pf) acc[pf][lf] = acc[pf][lf] * e; }
            bf16x8 xa[4], xnx[4];
#pragma unroll
            for (int pf = 0; pf < 4; ++pf) xnx[pf] = __builtin_nontemporal_load((const bf16x8*)(XDTT + uh * 16384 + (16 * pf + fr) * 256 + 8 * fq));
            for (int ks = 0; ks < S / 32; ++ks) {
                const int s0 = 32 * ks + 8 * fq;
                const int sn = 32 * (ks + 1 < S / 32 ? ks + 1 : ks) + 8 * fq;
#pragma unroll
                for (int pf = 0; pf < 4; ++pf) { xa[pf] = xnx[pf]; xnx[pf] = __builtin_nontemporal_load((const bf16x8*)(XDTT + uh * 16384 + (16 * pf + fr) * 256 + sn)); }
                const f32x4 as0 = *(const LAS f32x4*)(acsL + hh * 256 + s0), as1 = *(const LAS f32x4*)(acsL + hh * 256 + s0 + 4);
#pragma unroll
                for (int lf = 0; lf < 4; ++lf) {
                    if (32 * ks > l0 + 16 * lf + 15) continue;
                    const int l = l0 + 16 * lf + fr;
                    const f32x4 c0 = *(const LAS f32x4*)(CB + (16 * lf + fr) * 260 + s0), c1 = *(const LAS f32x4*)(CB + (16 * lf + fr) * 260 + s0 + 4);
                    const float a_l = al[lf];
                    typedef float f2_ __attribute__((ext_vector_type(2)));
                    const f2_ al2 = {a_l, a_l};
                    f2_ t0 = (al2 - (f2_){as0.x, as0.y}) * 1.44269504f, t1 = (al2 - (f2_){as0.z, as0.w}) * 1.44269504f, t2 = (al2 - (f2_){as1.x, as1.y}) * 1.44269504f, t3 = (al2 - (f2_){as1.z, as1.w}) * 1.44269504f;
                    f2_ e0, e1, e2, e3;
                    e0.x = __builtin_amdgcn_exp2f(t0.x); e0.y = __builtin_amdgcn_exp2f(t0.y); e1.x = __builtin_amdgcn_exp2f(t1.x); e1.y = __builtin_amdgcn_exp2f(t1.y);
                    e2.x = __builtin_amdgcn_exp2f(t2.x); e2.y = __builtin_amdgcn_exp2f(t2.y); e3.x = __builtin_amdgcn_exp2f(t3.x); e3.y = __builtin_amdgcn_exp2f(t3.y);
                    e0 = e0 * (f2_){c0.x, c0.y}; e1 = e1 * (f2_){c0.z, c0.w}; e2 = e2 * (f2_){c1.x, c1.y}; e3 = e3 * (f2_){c1.z, c1.w};
                    const float m0 = (s0 + 0 <= l) ? e0.x : 0.f, m1 = (s0 + 1 <= l) ? e0.y : 0.f, m2 = (s0 + 2 <= l) ? e1.x : 0.f, m3 = (s0 + 3 <= l) ? e1.y : 0.f;
                    const float m4 = (s0 + 4 <= l) ? e2.x : 0.f, m5 = (s0 + 5 <= l) ? e2.y : 0.f, m6 = (s0 + 6 <= l) ? e3.x : 0.f, m7 = (s0 + 7 <= l) ? e3.y : 0.f;
                    v4u mw; mw.x = pk2(m0, m1); mw.y = pk2(m2, m3); mw.z = pk2(m4, m5); mw.w = pk2(m6, m7);
                    const bf16x8 mb = __builtin_bit_cast(bf16x8, mw);
#pragma unroll
                    for (int pf = 0; pf < 4; ++pf) acc[pf][lf] = MFMA16(xa[pf], mb, acc[pf][lf]);
                }
            }
            const float Dh = a.in[16][h];
            float ssq[4];
#pragma unroll
            for (int lf = 0; lf < 4; ++lf) {
                const size_t row = (size_t)(rowc + l0 + 16 * lf + fr); float s2 = 0.f;
#pragma unroll
                for (int pf = 0; pf < 4; ++pf) {
                    const int chn = h * 64 + 16 * pf + 4 * fq;
                    const v2u xv = __builtin_nontemporal_load((const v2u*)(XS + row * 1024 + chn)), zv = __builtin_nontemporal_load((const v2u*)(ZB + row * 1024 + chn));
                    f32x4 y = acc[pf][lf];
                    y.x = (y.x + Dh * bflo(xv.x)) * bflo(zv.x); y.y = (y.y + Dh * bfhi(xv.x)) * bfhi(zv.x); y.z = (y.z + Dh * bflo(xv.y)) * bflo(zv.y); y.w = (y.w + Dh * bfhi(xv.y)) * bfhi(zv.y);
                    acc[pf][lf] = y; s2 += (y.x * y.x + y.y * y.y) + (y.z * y.z + y.w * y.w);
                }
                s2 += __shfl_xor(s2, 16); s2 += __shfl_xor(s2, 32); ssq[lf] = s2;
                if (fq == 0) ssL[hh * 64 + 16 * lf + fr] = s2;
            }
            __syncthreads();
#pragma unroll
            for (int lf = 0; lf < 4; ++lf) {
                float tot = 0.f;
#pragma unroll
                for (int w = 0; w < 8; ++w) tot += ssL[w * 64 + 16 * lf + fr];
                const float rs = __frsqrt_rn(tot * (1.0f / 512.0f) + EPS);
                const size_t row = (size_t)(rowc + l0 + 16 * lf + fr);
#pragma unroll
                for (int pf = 0; pf < 4; ++pf) {
                    const int chn = h * 64 + 16 * pf + 4 * fq;
                    const f32x4 gn = *(const f32x4*)(a.in[17] + chn); const f32x4 y = acc[pf][lf];
                    v2u o; o.x = pk2(y.x * rs * gn.x, y.y * rs * gn.y); o.y = pk2(y.z * rs * gn.z, y.w * rs * gn.w);
                    *(v2u*)(YCAT + row * D + 1024 + chn) = o;
                }
            }
            __syncthreads();
        }
    }
    GRID_SYNC();
    { pg8::Gemm g{YCAT, WOUT, M, D, D}; pg8::StaticOrder S; S.init(M, D, G, bx); pg8::EpiBf16P E{HF2, D};
      pg8::gemm_phase<pg8::EpiBf16P, pg8::StaticOrder, true, true>(lds, g, S, E); }
    GRID_SYNC();
    {
        int tid = threadIdx.x; asm volatile("" : "+v"(tid)); const int lane = tid & 63, fr = lane & 15, fq = lane >> 4, gt = bx * 512 + tid; (void)fr; (void)fq; (void)gt;
        row_pass<1, true, true>(gw, NGW, lane, HF2, X1, X2, 1.0f, a.in[7], a.in[19], XN);
    }
    GRID_SYNC();
    { pg8::Gemm g{XN, WGU2, M, NGU, D}; pg8::StaticOrder S; S.init(M, NGU, G, bx); pg8::EpiSwiGLU E{HB, FF};
      pg8::gemm_phase<pg8::EpiSwiGLU, pg8::StaticOrder, true, true>(lds, g, S, E); }
    GRID_SYNC();
    { pg8::Gemm g{HB, WD2, M, D, FF}; pg8::StaticOrder S; S.init(M, D, G, bx); pg8::EpiBf16P E{HF3, D};
      pg8::gemm_phase<pg8::EpiBf16P, pg8::StaticOrder, true, true>(lds, g, S, E); }
    GRID_SYNC();
    {
        int tid = threadIdx.x; asm volatile("" : "+v"(tid)); const int lane = tid & 63, fr = lane & 15, fq = lane >> 4, gt = bx * 512 + tid; (void)fr; (void)fq; (void)gt;
        row_pass<2, true, false>(gw, NGW, lane, HF3, X2, out, 0.5f, a.in[20], nullptr, nullptr);
    }
}

extern "C" void kernel_launch(void* const* d_in, const int* in_sizes, int n_in, void* d_out, int out_size, void* d_ws, size_t ws_size, hipStream_t stream) {
    static int grid = 0;
    if (grid == 0) {
        if (n_in != 24 || out_size != M * D || ws_size < WS_END) { fprintf(stderr, "kernel_launch: unexpected shapes (n_in %d out %d ws %zu)\n", n_in, out_size, ws_size); grid = -1; return; }
        int dev = 0, cus = 0, per_cu = 0;
        hipGetDevice(&dev); hipDeviceGetAttribute(&cus, hipDeviceAttributeMultiprocessorCount, dev);
        if (hipFuncSetAttribute((const void*)fwd_mega, hipFuncAttributeMaxDynamicSharedMemorySize, LDS_BYTES) != hipSuccess) { fprintf(stderr, "kernel_launch: hipFuncSetAttribute failed\n"); grid = -1; return; }
        if (hipOccupancyMaxActiveBlocksPerMultiprocessor(&per_cu, (const void*)fwd_mega, 512, LDS_BYTES) != hipSuccess || per_cu < 1) { fprintf(stderr, "kernel_launch: occupancy query gave %d\n", per_cu); per_cu = 1; }
        (void)hipGetLastError();
        grid = cus * 1;
    }
    if (grid < 0) return;
    Args a{};
    for (int i = 0; i < 24; ++i) a.in[i] = (const float*)d_in[i];
    a.out = (float*)d_out; a.ws = (unsigned char*)d_ws;
    if (hipMemsetAsync((char*)d_ws + WS_BAR, 0, 16384, stream) != hipSuccess) { fprintf(stderr, "kernel_launch: memset failed\n"); return; }
    void* args[] = {&a};
    hipError_t e = hipLaunchCooperativeKernel((const void*)fwd_mega, dim3(grid), dim3(512), args, LDS_BYTES, stream);
    if (e != hipSuccess) fprintf(stderr, "cooperative launch failed: %s (grid %d)\n", hipGetErrorString(e), grid);
}
```

```cpp
#include <hip/hip_runtime.h>
#include <hip/hip_cooperative_groups.h>
#include <cstdio>
namespace cg = cooperative_groups;
namespace pg8 {
#define PG8_LAS __attribute__((address_space(3)))
typedef unsigned short bf16_t;
typedef short bf16x8 __attribute__((ext_vector_type(8)));
typedef float f32x4 __attribute__((ext_vector_type(4)));
typedef unsigned u32x4 __attribute__((ext_vector_type(4)));
constexpr int BM = 256, BK = 64, HALF = 128, HTB = HALF * BK * 2  , STAGE_BYTES = 8 * HTB, NXCD = 8, WGM = 8;

__host__ __device__ __forceinline__ int lds_byte(int r, int c) { const int st = (r >> 4) * 2 + (c >> 5), rr = r & 15, cc = c & 31, ob = rr * 64 + cc * 2; return st * 1024 + (ob ^ (((ob >> 9) & 1) << 5)); }
__host__ __device__ __forceinline__ void stage_rc(int b, int& R, int& C) { const int st = b / 1024, sb = b % 1024, swz = sb ^ (((sb >> 9) & 1) << 5); R = (st >> 1) * 16 + swz / 64; C = (st & 1) * 32 + (swz % 64) / 2; }
__host__ __device__ __forceinline__ int perm32(int rho) { const int n = rho >> 4, i = rho & 15; return 8 * (i >> 2) + 4 * n + (i & 3); }

struct Unit { int pm, pn; };
struct Gemm { const bf16_t* A; const bf16_t* Bt; int M, N, K; };

struct StaticOrder {
    int nM, nN, nwg, G, c;
    __host__ __device__ void init(int M, int N, int G_, int c_) { nM = M / BM; nN = N / BM; nwg = nM * nN; G = G_; c = c_; }
    __host__ __device__ bool next(int i, Unit& u) const {
        const long L = (long)i * G + c; if (L >= nwg) return false;
        int wgid = (int)L; { const int q = nwg / NXCD, r = nwg % NXCD, xcd = wgid % NXCD, off = wgid / NXCD; wgid = (xcd < r ? xcd * (q + 1) : r * (q + 1) + (xcd - r) * q) + off; }
        const int nig = WGM * nN, gid = wgid / nig, fm = gid * WGM, gsz = (nM - fm) < WGM ? (nM - fm) : WGM;
        u.pm = fm + ((wgid % nig) % gsz); u.pn = (wgid % nig) / gsz; return true;
    }
    __device__ __forceinline__ void a_ready(const Unit&) const {}
    __device__ __forceinline__ void done(const Unit&) const {}
};
struct CountedOrder : StaticOrder {
    const unsigned* ready; unsigned need; unsigned* tmo;
    __device__ __forceinline__ void a_ready(const Unit& u) const {
        if (threadIdx.x < 64) {
            const unsigned long long t0 = __builtin_amdgcn_s_memrealtime(); unsigned polls = 0;
            while ((unsigned)__builtin_amdgcn_readfirstlane(__hip_atomic_load(ready + 64 * u.pm, __ATOMIC_RELAXED, __HIP_MEMORY_SCOPE_AGENT)) < need) {
                if ((++polls & 255u) == 0u && __builtin_amdgcn_readfirstlane(__hip_atomic_load(tmo, __ATOMIC_RELAXED, __HIP_MEMORY_SCOPE_AGENT)) != 0u) break;
                if (__builtin_amdgcn_s_memrealtime() - t0 > 2000000ull) {
                    if (threadIdx.x == 0) { unsigned expect = 0u; __hip_atomic_compare_exchange_strong(tmo + 1, &expect, 0x600u | (unsigned)(u.pm & 0xff), __ATOMIC_RELAXED, __ATOMIC_RELAXED, __HIP_MEMORY_SCOPE_AGENT); __hip_atomic_store(tmo, 1u, __ATOMIC_RELAXED, __HIP_MEMORY_SCOPE_AGENT); }
                    break; }
                __builtin_amdgcn_s_sleep(2); }
            __builtin_amdgcn_fence(__ATOMIC_ACQUIRE, "agent");
            asm volatile("s_waitcnt vmcnt(0)" ::: "memory");
        }
#if !defined(BROKEN_HOOK_NO_BARRIER)
        asm volatile("" ::: "memory"); __builtin_amdgcn_s_barrier(); asm volatile("" ::: "memory");
#endif
    }
};

__device__ __forceinline__ unsigned cvt_pk_bf16(float lo, float hi) { unsigned r; asm volatile("v_cvt_pk_bf16_f32 %0, %1, %2" : "=v"(r) : "v"(lo), "v"(hi)); return r; }
typedef float f32x2 __attribute__((ext_vector_type(2)));
__device__ __forceinline__ f32x2 gelu_pk(f32x2 v) {
    const f32x2 av = __builtin_elementwise_abs(v), d = av * 0.2316418882f + 1.0f;
    f32x2 t; t.x = __builtin_amdgcn_rcpf(d.x); t.y = __builtin_amdgcn_rcpf(d.y);
    f32x2 q = t * 0.5307027145f + (-0.7265760135f); q = q * t + 0.7107068705f; q = q * t + (-0.142248368f); q = q * t + 0.127414796f; q = q * t;
    const f32x2 s = (v * v) * (-0.72134752044f);
    f32x2 e; e.x = __builtin_amdgcn_exp2f(s.x); e.y = __builtin_amdgcn_exp2f(s.y);
    const f32x2 m = v * (q * e), r = v - m;
    f32x2 o; o.x = v.x < 0.f ? m.x : r.x; o.y = v.y < 0.f ? m.y : r.y; return o;
}

struct EpiF32 {
    static constexpr bool PERM = false, AFTER_DRAIN = false;
    float* C; int ldc; const float* bias;
    __device__ __forceinline__ void operator()(const f32x4 (&acc)[2][2][4][2], const Unit& u, int wr, int wc, int fr, int fq) const {
        const int row0 = u.pm * BM + wr * 64 + fr, col0 = u.pn * BM + wc * 32 + 4 * fq;
        f32x4 bv[2][2];
#pragma unroll
        for (int bj = 0; bj < 2; ++bj)
#pragma unroll
            for (int n = 0; n < 2; ++n) bv[bj][n] = bias ? *(const f32x4*)(bias + col0 + bj * HALF + n * 16) : (f32x4){0.f, 0.f, 0.f, 0.f};
#pragma unroll
        for (int ai = 0; ai < 2; ++ai)
#pragma unroll
            for (int m = 0; m < 4; ++m) { float* rowp = C + (size_t)(row0 + ai * HALF + m * 16) * ldc + col0;
#pragma unroll
                for (int bj = 0; bj < 2; ++bj)
#pragma unroll
                    for (int n = 0; n < 2; ++n) *(f32x4*)(rowp + bj * HALF + n * 16) = acc[ai][bj][m][n] + bv[bj][n]; }
    }
};
}
namespace pg8 {
__device__ __forceinline__ float silu_f(float g) { return g * __builtin_amdgcn_rcpf(1.0f + __expf(-g)); }
__device__ __forceinline__ void gelu_pk4(f32x2& a, f32x2& b, f32x2& c, f32x2& d) {
    const f32x2 aa = __builtin_elementwise_abs(a), ab = __builtin_elementwise_abs(b), ac = __builtin_elementwise_abs(c), ad = __builtin_elementwise_abs(d);
    const f32x2 da = aa * 0.2316418882f + 1.0f, db = ab * 0.2316418882f + 1.0f, dc = ac * 0.2316418882f + 1.0f, dd = ad * 0.2316418882f + 1.0f;
    f32x2 ta, tb, tc, td;
    ta.x = __builtin_amdgcn_rcpf(da.x); ta.y = __builtin_amdgcn_rcpf(da.y); tb.x = __builtin_amdgcn_rcpf(db.x); tb.y = __builtin_amdgcn_rcpf(db.y);
    tc.x = __builtin_amdgcn_rcpf(dc.x); tc.y = __builtin_amdgcn_rcpf(dc.y); td.x = __builtin_amdgcn_rcpf(dd.x); td.y = __builtin_amdgcn_rcpf(dd.y);
    const f32x2 sa = (a * a) * (-0.72134752044f), sb = (b * b) * (-0.72134752044f), sc = (c * c) * (-0.72134752044f), sd = (d * d) * (-0.72134752044f);
    f32x2 ea, eb, ec, ed;
    ea.x = __builtin_amdgcn_exp2f(sa.x); ea.y = __builtin_amdgcn_exp2f(sa.y); eb.x = __builtin_amdgcn_exp2f(sb.x); eb.y = __builtin_amdgcn_exp2f(sb.y);
    ec.x = __builtin_amdgcn_exp2f(sc.x); ec.y = __builtin_amdgcn_exp2f(sc.y); ed.x = __builtin_amdgcn_exp2f(sd.x); ed.y = __builtin_amdgcn_exp2f(sd.y);
    f32x2 qa = ta * 0.5307027145f + (-0.7265760135f), qb = tb * 0.5307027145f + (-0.7265760135f), qc = tc * 0.5307027145f + (-0.7265760135f), qd = td * 0.5307027145f + (-0.7265760135f);
    qa = qa * ta + 0.7107068705f; qb = qb * tb + 0.7107068705f; qc = qc * tc + 0.7107068705f; qd = qd * td + 0.7107068705f;
    qa = qa * ta + (-0.142248368f); qb = qb * tb + (-0.142248368f); qc = qc * tc + (-0.142248368f); qd = qd * td + (-0.142248368f);
    qa = qa * ta + 0.127414796f; qb = qb * tb + 0.127414796f; qc = qc * tc + 0.127414796f; qd = qd * td + 0.127414796f;
    qa = qa * ta; qb = qb * tb; qc = qc * tc; qd = qd * td;
    const f32x2 ma = a * (qa * ea), mb = b * (qb * eb), mc = c * (qc * ec), md = d * (qd * ed);
    const f32x2 ra = a - ma, rb = b - mb, rc = c - mc, rd = d - md;
    f32x2 oa, ob, oc, od;
    oa.x = a.x < 0.f ? ma.x : ra.x; oa.y = a.y < 0.f ? ma.y : ra.y; ob.x = b.x < 0.f ? mb.x : rb.x; ob.y = b.y < 0.f ? mb.y : rb.y;
    oc.x = c.x < 0.f ? mc.x : rc.x; oc.y = c.y < 0.f ? mc.y : rc.y; od.x = d.x < 0.f ? md.x : rd.x; od.y = d.y < 0.f ? md.y : rd.y;
    a = oa; b = ob; c = oc; d = od;
}
__device__ __forceinline__ void silu_pk4(f32x2& a, f32x2& b, f32x2& c, f32x2& d) {
    const f32x2 ta = a * -1.44269504f, tb = b * -1.44269504f, tc = c * -1.44269504f, td = d * -1.44269504f;
    f32x2 ea, eb, ec, ed;
    ea.x = __builtin_amdgcn_exp2f(ta.x); ea.y = __builtin_amdgcn_exp2f(ta.y); eb.x = __builtin_amdgcn_exp2f(tb.x); eb.y = __builtin_amdgcn_exp2f(tb.y);
    ec.x = __builtin_amdgcn_exp2f(tc.x); ec.y = __builtin_amdgcn_exp2f(tc.y); ed.x = __builtin_amdgcn_exp2f(td.x); ed.y = __builtin_amdgcn_exp2f(td.y);
    ea = ea + 1.0f; eb = eb + 1.0f; ec = ec + 1.0f; ed = ed + 1.0f;
    f32x2 ra, rb, rc, rd;
    ra.x = __builtin_amdgcn_rcpf(ea.x); ra.y = __builtin_amdgcn_rcpf(ea.y); rb.x = __builtin_amdgcn_rcpf(eb.x); rb.y = __builtin_amdgcn_rcpf(eb.y);
    rc.x = __builtin_amdgcn_rcpf(ec.x); rc.y = __builtin_amdgcn_rcpf(ec.y); rd.x = __builtin_amdgcn_rcpf(ed.x); rd.y = __builtin_amdgcn_rcpf(ed.y);
    a = a * ra; b = b * rb; c = c * rc; d = d * rd;
}
struct EpiSwiGLU {
    static constexpr bool PERM = true, AFTER_DRAIN = false;
    bf16_t* O; int ldc;
    __device__ __forceinline__ void operator()(const f32x4 (&acc)[2][2][4][2], const Unit& u, int wr, int wc, int fr, int fq) const {
        const int row0 = u.pm * BM + wr * 64 + fr, col0 = u.pn * 128 + wc * 32 + 8 * fq;
#pragma unroll
        for (int ai = 0; ai < 2; ++ai)
#pragma unroll
            for (int m = 0; m < 4; ++m) {
                bf16_t* rowp = O + (size_t)(row0 + ai * HALF + m * 16) * ldc + col0;
                const f32x4 g0 = acc[ai][0][m][0], g1 = acc[ai][0][m][1], u0 = acc[ai][1][m][0], u1 = acc[ai][1][m][1];
                f32x2 ga = {g0[0], g0[1]}, gb = {g0[2], g0[3]}, gc = {g1[0], g1[1]}, gd = {g1[2], g1[3]};
                f32x2 ta = ga * -1.44269504f, tb = gb * -1.44269504f, tc = gc * -1.44269504f, td = gd * -1.44269504f;
                f32x2 ea, eb, ec, ed;
                ea.x = __builtin_amdgcn_exp2f(ta.x); ea.y = __builtin_amdgcn_exp2f(ta.y); eb.x = __builtin_amdgcn_exp2f(tb.x); eb.y = __builtin_amdgcn_exp2f(tb.y);
                ec.x = __builtin_amdgcn_exp2f(tc.x); ec.y = __builtin_amdgcn_exp2f(tc.y); ed.x = __builtin_amdgcn_exp2f(td.x); ed.y = __builtin_amdgcn_exp2f(td.y);
                ea = ea + 1.0f; eb = eb + 1.0f; ec = ec + 1.0f; ed = ed + 1.0f;
                f32x2 pa = ga * (f32x2){u0[0], u0[1]}, pb = gb * (f32x2){u0[2], u0[3]}, pc = gc * (f32x2){u1[0], u1[1]}, pd = gd * (f32x2){u1[2], u1[3]};
                f32x2 ra, rb, rc, rd;
                ra.x = __builtin_amdgcn_rcpf(ea.x); ra.y = __builtin_amdgcn_rcpf(ea.y); rb.x = __builtin_amdgcn_rcpf(eb.x); rb.y = __builtin_amdgcn_rcpf(eb.y);
                rc.x = __builtin_amdgcn_rcpf(ec.x); rc.y = __builtin_amdgcn_rcpf(ec.y); rd.x = __builtin_amdgcn_rcpf(ed.x); rd.y = __builtin_amdgcn_rcpf(ed.y);
                pa = pa * ra; pb = pb * rb; pc = pc * rc; pd = pd * rd;
                u32x4 w;
                w.x = cvt_pk_bf16(pa.x, pa.y); w.y = cvt_pk_bf16(pb.x, pb.y); w.z = cvt_pk_bf16(pc.x, pc.y); w.w = cvt_pk_bf16(pd.x, pd.y);
                __builtin_nontemporal_store(w, (u32x4*)rowp);
            }
    }
};
struct EpiBf16P {
    static constexpr bool PERM = true, AFTER_DRAIN = false;
    bf16_t* O; int ldc;
    __device__ __forceinline__ void operator()(const f32x4 (&acc)[2][2][4][2], const Unit& u, int wr, int wc, int fr, int fq) const {
        const int row0 = u.pm * BM + wr * 64 + fr, col0 = u.pn * BM + wc * 32 + 8 * fq;
#pragma unroll
        for (int ai = 0; ai < 2; ++ai)
#pragma unroll
            for (int m = 0; m < 4; ++m) { bf16_t* rowp = O + (size_t)(row0 + ai * HALF + m * 16) * ldc + col0;
#pragma unroll
                for (int bj = 0; bj < 2; ++bj) { const f32x4 v0 = acc[ai][bj][m][0], v1 = acc[ai][bj][m][1];
                    u32x4 w; w.x = cvt_pk_bf16(v0[0], v0[1]); w.y = cvt_pk_bf16(v0[2], v0[3]); w.z = cvt_pk_bf16(v1[0], v1[1]); w.w = cvt_pk_bf16(v1[2], v1[3]);
                    *(u32x4*)(rowp + bj * HALF) = w; } }
    }
};
struct EpiHS {
    static constexpr bool PERM = true, AFTER_DRAIN = false;
    bf16_t* O; int ldc; float* HQ;
    __device__ __forceinline__ void operator()(const f32x4 (&acc)[2][2][4][2], const Unit& u, int wr, int wc, int fr, int fq) const {
        const int row0 = u.pm * BM + wr * 64 + fr, col0 = u.pn * BM + wc * 32 + 8 * fq;
#pragma unroll
        for (int ai = 0; ai < 2; ++ai)
#pragma unroll
            for (int m = 0; m < 4; ++m) { bf16_t* rowp = O + (size_t)(row0 + ai * HALF + m * 16) * ldc + col0; float ssq = 0.f;
#pragma unroll
                for (int bj = 0; bj < 2; ++bj) { const f32x4 v0 = acc[ai][bj][m][0], v1 = acc[ai][bj][m][1];
                    ssq += (v0[0] * v0[0] + v0[1] * v0[1]) + (v0[2] * v0[2] + v0[3] * v0[3]) + (v1[0] * v1[0] + v1[1] * v1[1]) + (v1[2] * v1[2] + v1[3] * v1[3]);
                    u32x4 w; w.x = cvt_pk_bf16(v0[0], v0[1]); w.y = cvt_pk_bf16(v0[2], v0[3]); w.z = cvt_pk_bf16(v1[0], v1[1]); w.w = cvt_pk_bf16(v1[2], v1[3]);
                    *(u32x4*)(rowp + bj * HALF) = w; }
                ssq += __shfl_xor(ssq, 16); ssq += __shfl_xor(ssq, 32);
                if (fq == 0) __hip_atomic_fetch_add(HQ + (((u.pm * 2 + wr) * 16 + fr) * 8 + ai * 4 + m), ssq, __ATOMIC_RELAXED, __HIP_MEMORY_SCOPE_AGENT); }
    }
};
struct EpiInProj {
    static constexpr bool PERM = true, AFTER_DRAIN = false;
    bf16_t *GU, *GV, *Z, *XBC; float* vss;
    __device__ __forceinline__ void operator()(const f32x4 (&acc)[2][2][4][2], const Unit& u, int wr, int wc, int fr, int fq) const {
        const int pn = u.pn; const int row0 = u.pm * BM + wr * 64 + fr;
        bf16_t* base; int ldc, colt, mode;
        if (pn < 4) { base = GU; ldc = 1024; colt = pn * 256; mode = 0; }
        else if (pn < 8) { base = GV; ldc = 1024; colt = (pn - 4) * 256; mode = 1; }
        else if (pn < 12) { base = Z; ldc = 1024; colt = (pn - 8) * 256; mode = 2; }
        else { base = XBC; ldc = 1536; colt = (pn - 12) * 256; mode = 3; }
        const int col0 = colt + wc * 32 + 8 * fq;
#pragma unroll
        for (int ai = 0; ai < 2; ++ai)
#pragma unroll
            for (int m = 0; m < 4; ++m) {
                const int row = row0 + ai * HALF + m * 16;
                bf16_t* rowp = base + (size_t)row * ldc + col0; float ssq = 0.f;
#pragma unroll
                for (int bj = 0; bj < 2; ++bj) {
                    f32x4 v0 = acc[ai][bj][m][0], v1 = acc[ai][bj][m][1];
                    if (mode <= 1) {
                        f32x2 a = {v0[0], v0[1]}, b = {v0[2], v0[3]}, c = {v1[0], v1[1]}, d = {v1[2], v1[3]};
                        gelu_pk4(a, b, c, d);
                        v0 = (f32x4){a.x, a.y, b.x, b.y}; v1 = (f32x4){c.x, c.y, d.x, d.y};
                        ssq += (v0[0] * v0[0] + v0[1] * v0[1]) + (v0[2] * v0[2] + v0[3] * v0[3]) + (v1[0] * v1[0] + v1[1] * v1[1]) + (v1[2] * v1[2] + v1[3] * v1[3]);
                    } else if (mode == 2) {
                        f32x2 a = {v0[0], v0[1]}, b = {v0[2], v0[3]}, c = {v1[0], v1[1]}, d = {v1[2], v1[3]};
                        silu_pk4(a, b, c, d);
                        v0 = (f32x4){a.x, a.y, b.x, b.y}; v1 = (f32x4){c.x, c.y, d.x, d.y};
                    }
                    u32x4 w; w.x = cvt_pk_bf16(v0[0], v0[1]); w.y = cvt_pk_bf16(v0[2], v0[3]); w.z = cvt_pk_bf16(v1[0], v1[1]); w.w = cvt_pk_bf16(v1[2], v1[3]);
                    *(u32x4*)(rowp + bj * HALF) = w;
                }
                if (mode == 1) { ssq += __shfl_xor(ssq, 16); ssq += __shfl_xor(ssq, 32); if (fq == 0) unsafeAtomicAdd(vss + row, ssq); }
            }
    }
};
}
namespace pg8 {
template <class Epi, class Sched, bool ALIGN_EPI = false, bool SP2 = false>
__device__ __forceinline__ void gemm_phase(PG8_LAS unsigned char* lds, const Gemm g, const Sched& S, const Epi& E) {
    const int tid = threadIdx.x, wid = __builtin_amdgcn_readfirstlane(tid >> 6), lane = tid & 63, wr = wid >> 2, wc = wid & 3, fr = lane & 15, fq = lane >> 4;
    const int K = g.K, nt = K / BK;
    unsigned voffA[2], voffB[2];
#pragma unroll
    for (int i = 0; i < 2; ++i) { int R, C; stage_rc(tid * 16 + i * 8192, R, C); const int Rb = Epi::PERM ? ((R & ~31) + perm32(R & 31)) : R;
        voffA[i] = (unsigned)(R * K + C) * 2u; voffB[i] = (unsigned)(Rb * K + C) * 2u; }
    const size_t kstep = (size_t)(BK * 2);
    const size_t hstep = (size_t)HALF * K * 2;
    const size_t tstep = 2 * hstep;
    const unsigned ldsw = (unsigned)wid * 1024u;
    const int aoff = lds_byte(wr * 64 + fr, fq * 8), boff = lds_byte(wc * 32 + fr, fq * 8);
#define PG8_SA(b, h) (((b) * 2 + (h)) * HTB)
#define PG8_SB(b, h) ((4 + (b) * 2 + (h)) * HTB)
#define PG8_STAGE(bufoff, gbase, voff) do { _Pragma("unroll") for (int _i = 0; _i < 2; ++_i) \
        __builtin_amdgcn_global_load_lds((const unsigned*)((const char*)(gbase) + (voff)[_i]), (PG8_LAS unsigned*)(lds + (bufoff) + ldsw + _i * 8192), 16, 0, 0); } while (0)
#define PG8_LDA(dst, b, h) do { _Pragma("unroll") for (int m = 0; m < 4; ++m) _Pragma("unroll") for (int k = 0; k < 2; ++k) dst[m][k] = *(const PG8_LAS bf16x8*)(lds + PG8_SA(b, h) + aoff + m * 2048 + k * 1024); } while (0)
#define PG8_LDB(dst, b, h) do { _Pragma("unroll") for (int n = 0; n < 2; ++n) _Pragma("unroll") for (int k = 0; k < 2; ++k) dst[n][k] = *(const PG8_LAS bf16x8*)(lds + PG8_SB(b, h) + boff + n * 2048 + k * 1024); } while (0)
#define PG8_MMA(ai, bj, At, Bt) do { __builtin_amdgcn_s_setprio(1); _Pragma("unroll") for (int k = 0; k < 2; ++k) _Pragma("unroll") for (int m = 0; m < 4; ++m) _Pragma("unroll") for (int n = 0; n < 2; ++n) \
        acc[ai][bj][m][n] = __builtin_amdgcn_mfma_f32_16x16x32_bf16(Bt[n][k], At[m][k], acc[ai][bj][m][n], 0, 0, 0); __builtin_amdgcn_s_setprio(0); } while (0)
#define PG8_WAIT_V(n) asm volatile("s_waitcnt vmcnt(" #n ")" ::: "memory")
#define PG8_WAIT_L(n) asm volatile("s_waitcnt lgkmcnt(" #n ")" ::: "memory")
#define PG8_BAR __builtin_amdgcn_s_barrier()
#define PG8_SCHED __builtin_amdgcn_sched_barrier(0)
    Unit cur, nxt; int ui = 0;
    if (!S.next(0, cur)) return;
    f32x4 acc[2][2][4][2];
#pragma unroll
    for (int a = 0; a < 2; ++a)
#pragma unroll
        for (int b = 0; b < 2; ++b)
#pragma unroll
            for (int m = 0; m < 4; ++m)
#pragma unroll
                for (int n = 0; n < 2; ++n) acc[a][b][m][n] = (f32x4){0.f, 0.f, 0.f, 0.f};
    bf16x8 At[4][2], B0[2][2], B1[2][2];
    const char* cA = (const char*)g.A + (size_t)cur.pm * tstep; const char* cB = (const char*)g.Bt + (size_t)cur.pn * tstep;
    S.a_ready(cur);
    if constexpr (SP2) {
        PG8_STAGE(PG8_SB(0, 0), cB, voffB); PG8_STAGE(PG8_SB(0, 1), cB + hstep, voffB); PG8_STAGE(PG8_SA(0, 0), cA, voffA); PG8_STAGE(PG8_SA(0, 1), cA + hstep, voffA);
        if (wr == 1) PG8_BAR;
        PG8_WAIT_V(2); PG8_BAR;
        PG8_STAGE(PG8_SB(1, 0), cB + kstep, voffB); PG8_STAGE(PG8_SA(1, 0), cA + kstep, voffA); PG8_STAGE(PG8_SB(1, 1), cB + hstep + kstep, voffB);
        PG8_WAIT_V(6); PG8_BAR;
    } else {
        PG8_STAGE(PG8_SB(0, 0), cB, voffB); PG8_STAGE(PG8_SA(0, 0), cA, voffA); PG8_STAGE(PG8_SB(0, 1), cB + hstep, voffB); PG8_STAGE(PG8_SA(0, 1), cA + hstep, voffA);
        if (wr == 1) PG8_BAR;
        PG8_WAIT_V(4); PG8_BAR;
        PG8_STAGE(PG8_SB(1, 0), cB + kstep, voffB); PG8_STAGE(PG8_SA(1, 0), cA + kstep, voffA); PG8_STAGE(PG8_SB(1, 1), cB + hstep + kstep, voffB);
        PG8_WAIT_V(6); PG8_BAR;
    }
    for (;;) {
        const bool has_next = S.next(ui + 1, nxt);
        const char* nA = has_next ? (const char*)g.A + (size_t)nxt.pm * tstep : cA; const char* nB = has_next ? (const char*)g.Bt + (size_t)nxt.pn * tstep : cB;
        for (int t = 0; t < nt; t += 2) {
            const bool last = (t == nt - 2);
            const char* a1 = cA + (size_t)(t + 1) * kstep;
            const char* a2 = last ? nA : cA + (size_t)(t + 2) * kstep; const char* b2 = last ? nB : cB + (size_t)(t + 2) * kstep;
            const char* a3 = a2 + kstep; const char* b3 = b2 + kstep;
            if (last && has_next) S.a_ready(nxt);
            if constexpr (SP2) {
            PG8_LDB(B0, 0, 0); PG8_LDB(B1, 0, 1); PG8_SCHED; PG8_LDA(At, 0, 0); PG8_STAGE(PG8_SA(1, 1), a1 + hstep, voffA);
            PG8_WAIT_V(8); PG8_WAIT_L(0); PG8_BAR; PG8_MMA(0, 0, At, B0); PG8_MMA(0, 1, At, B1); PG8_BAR; PG8_SCHED;
            PG8_LDA(At, 0, 1); PG8_STAGE(PG8_SB(0, 0), b2, voffB); PG8_STAGE(PG8_SB(0, 1), b2 + hstep, voffB); PG8_STAGE(PG8_SA(0, 0), a2, voffA);
            PG8_WAIT_V(8); PG8_WAIT_L(0); PG8_BAR; PG8_MMA(1, 0, At, B0); PG8_MMA(1, 1, At, B1); PG8_BAR; PG8_SCHED;
            PG8_LDB(B0, 1, 0); PG8_LDB(B1, 1, 1); PG8_SCHED; PG8_LDA(At, 1, 0); PG8_STAGE(PG8_SA(0, 1), a2 + hstep, voffA);
            PG8_WAIT_V(8); PG8_WAIT_L(0); PG8_BAR; PG8_MMA(0, 0, At, B0); PG8_MMA(0, 1, At, B1); PG8_BAR; PG8_SCHED;
            PG8_LDA(At, 1, 1); PG8_STAGE(PG8_SB(1, 0), b3, voffB); PG8_STAGE(PG8_SB(1, 1), b3 + hstep, voffB); PG8_STAGE(PG8_SA(1, 0), a3, voffA);
            PG8_WAIT_V(8); PG8_WAIT_L(0); PG8_BAR; PG8_MMA(1, 0, At, B0); PG8_MMA(1, 1, At, B1); PG8_BAR; PG8_SCHED;
            } else {
            PG8_LDB(B0, 0, 0); PG8_SCHED; PG8_LDA(At, 0, 0); PG8_STAGE(PG8_SA(1, 1), a1 + hstep, voffA);
            PG8_WAIT_L(8); PG8_BAR; PG8_WAIT_L(0); PG8_MMA(0, 0, At, B0); PG8_BAR; PG8_SCHED;
            PG8_LDB(B1, 0, 1); PG8_STAGE(PG8_SB(0, 0), b2, voffB);
            PG8_BAR; PG8_WAIT_L(0); PG8_MMA(0, 1, At, B1); PG8_BAR;
            PG8_LDA(At, 0, 1); PG8_STAGE(PG8_SA(0, 0), a2, voffA);
            PG8_BAR; PG8_WAIT_L(0); PG8_MMA(1, 0, At, B0); PG8_BAR; PG8_SCHED;
            PG8_STAGE(PG8_SB(0, 1), b2 + hstep, voffB);
            PG8_WAIT_V(6); PG8_BAR; PG8_MMA(1, 1, At, B1); PG8_BAR;
            PG8_LDB(B0, 1, 0); PG8_SCHED; PG8_LDA(At, 1, 0); PG8_STAGE(PG8_SA(0, 1), a2 + hstep, voffA);
            PG8_WAIT_L(8); PG8_BAR; PG8_WAIT_L(0); PG8_MMA(0, 0, At, B0); PG8_BAR; PG8_SCHED;
            PG8_LDB(B1, 1, 1); PG8_STAGE(PG8_SB(1, 0), b3, voffB);
            PG8_BAR; PG8_WAIT_L(0); PG8_MMA(0, 1, At, B1); PG8_BAR;
            PG8_LDA(At, 1, 1); PG8_STAGE(PG8_SA(1, 0), a3, voffA);
            PG8_BAR; PG8_WAIT_L(0); PG8_MMA(1, 0, At, B0); PG8_BAR; PG8_SCHED;
            PG8_STAGE(PG8_SB(1, 1), b3 + hstep, voffB);
            PG8_WAIT_V(6); PG8_BAR; PG8_MMA(1, 1, At, B1); PG8_BAR;
            }
        }
        if constexpr (ALIGN_EPI) { if (wr == 0) PG8_BAR; }
        if constexpr (!Epi::AFTER_DRAIN) { E(acc, cur, wr, wc, fr, fq); S.done(cur); }
        if (!has_next) break;
#pragma unroll
        for (int a = 0; a < 2; ++a)
#pragma unroll
            for (int b = 0; b < 2; ++b)
#pragma unroll
                for (int m = 0; m < 4; ++m)
#pragma unroll
                    for (int n = 0; n < 2; ++n) acc[a][b][m][n] = (f32x4){0.f, 0.f, 0.f, 0.f};
        cur = nxt; cA = nA; cB = nB; ++ui;
        if constexpr (ALIGN_EPI) { if (wr == 1) PG8_BAR; }
    }
    PG8_WAIT_V(0);
    if constexpr (!ALIGN_EPI) { if (wr == 0) PG8_BAR; }
    PG8_BAR;
    if constexpr (Epi::AFTER_DRAIN) { E.fused(acc, cur, wr, wc, fr, fq, lds, wid, lane); S.done(cur); }
#undef PG8_SA
#undef PG8_SB
#undef PG8_STAGE
#undef PG8_LDA
#undef PG8_LDB
#undef PG8_MMA
#undef PG8_WAIT_V
#undef PG8_WAIT_L
#undef PG8_BAR
#undef PG8_SCHED
}
}
#define LAS __attribute__((address_space(3)))
typedef unsigned short bf16;
typedef unsigned v4u __attribute__((ext_vector_type(4)));
typedef unsigned v2u __attribute__((ext_vector_type(2)));
typedef float f32x4 __attribute__((ext_vector_type(4)));
typedef short bf16x8 __attribute__((ext_vector_type(8)));

constexpr int M = 16384, SEQ = 8192, D = 2048, FF = 5504, NGU = 2 * FF, AW = 1024, NIN = 4608, NINF = 4624, XBCW = 1536;
constexpr float EPS = 1e-6f;
constexpr size_t MiB = 1u << 20;
constexpr size_t WS_VSS = 0;
constexpr size_t WS_WGU1 = 1 * MiB, WS_WD1 = 44 * MiB, WS_WGU2 = 66 * MiB, WS_WD2 = 109 * MiB, WS_WIN = 131 * MiB, WS_WOUT = 150 * MiB, WS_WSP = 158 * MiB;
constexpr size_t WS_HB = 159 * MiB;
constexpr size_t WS_GU = 159 * MiB, WS_GV = 191 * MiB, WS_Z = 223 * MiB, WS_XBC = 255 * MiB, WS_DTRAW = 303 * MiB, WS_DT = 304 * MiB, WS_ACS = 305 * MiB, WS_BM = 306 * MiB, WS_CM = 314 * MiB;
constexpr size_t WS_HF2 = 159 * MiB;
constexpr size_t WS_XN = 331 * MiB;
constexpr size_t WS_YCAT = 331 * MiB;
constexpr size_t WS_XS = 395 * MiB, WS_XDTT = 427 * MiB, WS_ST = 459 * MiB, WS_PREV = 491 * MiB, WS_END = 507 * MiB;
constexpr size_t WS_HF3 = 331 * MiB;
static_assert(WS_HB + (size_t)M * FF * 2 <= WS_XN, "HB");
static_assert(WS_CM + 8 * MiB <= WS_XN, "map");

constexpr int LDS_BYTES = 147456;

__device__ __forceinline__ float bflo(unsigned w) { return __uint_as_float(w << 16); }
__device__ __forceinline__ float bfhi(unsigned w) { return __uint_as_float(w & 0xffff0000u); }
__device__ __forceinline__ unsigned pk2(float lo, float hi) { return pg8::cvt_pk_bf16(lo, hi); }
__device__ __forceinline__ unsigned short f2bf1(float f) { return (unsigned short)(pk2(f, 0.f) & 0xffffu); }
__device__ __forceinline__ float wave_sum(float v) {
#pragma unroll
    for (int o = 1; o < 64; o <<= 1) v += __shfl_xor(v, o);
    return v;
}
__device__ __forceinline__ float silu1(float g) { return g * __builtin_amdgcn_rcpf(1.0f + __expf(-g)); }
#define MFMA16(a, b, c) __builtin_amdgcn_mfma_f32_16x16x32_bf16((a), (b), (c), 0, 0, 0)

__device__ __forceinline__ void transpose_item(const float* W, int ldn, int K, bf16* WT, int k0, int n0, int drow0, LAS unsigned* T, int lane) {
    constexpr int STR = 66;
    const float* wp = W + (size_t)k0 * ldn + n0 + lane;
#pragma unroll
    for (int b = 0; b < 4; ++b) {
        float t[32];
#pragma unroll
        for (int i = 0; i < 32; ++i) t[i] = __builtin_nontemporal_load(wp + (size_t)(32 * b + i) * ldn);
#pragma unroll
        for (int i = 0; i < 16; ++i) T[lane * STR + 16 * b + i] = pk2(t[2 * i], t[2 * i + 1]);
        asm volatile("" ::: "memory");
    }
    asm volatile("s_waitcnt lgkmcnt(0)" ::: "memory");
    const int c = lane & 15, r = lane >> 4;
#pragma unroll
    for (int j = 0; j < 16; ++j) { const int row = 4 * j + r;
        const v2u lo = *(const LAS v2u*)(T + row * STR + 4 * c), hi = *(const LAS v2u*)(T + row * STR + 4 * c + 2);
        v4u o; o.x = lo.x; o.y = lo.y; o.z = hi.x; o.w = hi.y;
        *(v4u*)(WT + (size_t)(drow0 + row) * K + k0 + 8 * c) = o; }
    asm volatile("s_waitcnt lgkmcnt(0)" ::: "memory");
}
__device__ __forceinline__ void transpose_seg(const float* W, int ldn, int K, int nblk, bf16* WT, int mode, int item, LAS unsigned* T, int lane) {
    const int kb = item / nblk, nb = item % nblk, n0 = 64 * nb;
    const int drow0 = mode == 0 ? n0 : (n0 + 128 * (n0 >> 7) + (mode == 2 ? 128 : 0));
    transpose_item(W, ldn, K, WT, 128 * kb, n0, drow0, T, lane);
}

template <int MODE, bool XR_BF, bool XD_BF>
__device__ __forceinline__ void row_pass(int gw, int NGW, int lane, const bf16* hsrc, const void* xres_, void* xdst_, float sc, const float* gpost, const float* gpre, bf16* xn) {
    struct RowIn { f32x4 xf[XR_BF ? 1 : 8]; v2u xb[XR_BF ? 8 : 1]; v2u hb[MODE >= 1 ? 8 : 1]; };
#define ROW_LOAD(MM, R) do { \
        if constexpr (XR_BF) { const v2u* xr_ = (const v2u*)((const bf16*)xres_ + (size_t)(MM) * D) + lane; _Pragma("unroll") for (int j = 0; j < 8; ++j) R.xb[j] = __builtin_nontemporal_load(xr_ + 64 * j); } \
        else { const f32x4* xr_ = (const f32x4*)((const float*)xres_ + (size_t)(MM) * D) + lane; _Pragma("unroll") for (int j = 0; j < 8; ++j) R.xf[j] = __builtin_nontemporal_load(xr_ + 64 * j); } \
        if constexpr (MODE >= 1) { const v2u* hr_ = (const v2u*)(hsrc + (size_t)(MM) * D) + lane; _Pragma("unroll") for (int j = 0; j < 8; ++j) R.hb[j] = __builtin_nontemporal_load(hr_ + 64 * j); } } while (0)
    f32x4 gp[MODE >= 1 ? 8 : 1], gq[MODE != 2 ? 8 : 1];
    if constexpr (MODE >= 1) {
#pragma unroll
        for (int j = 0; j < 8; ++j) gp[j] = ((const f32x4*)gpost)[64 * j + lane]; }
    if constexpr (MODE != 2) {
#pragma unroll
        for (int j = 0; j < 8; ++j) gq[j] = ((const f32x4*)gpre)[64 * j + lane]; }
    RowIn cur{}, nxt{};
    if (gw < M) ROW_LOAD(gw, cur);
    for (int m = gw; m < M; m += NGW) {
        if (m + NGW < M) ROW_LOAD(m + NGW, nxt);
        f32x4 xv[8];
#pragma unroll
        for (int j = 0; j < 8; ++j) { if constexpr (XR_BF) { const v2u w = cur.xb[j]; xv[j] = (f32x4){bflo(w.x), bfhi(w.x), bflo(w.y), bfhi(w.y)}; } else xv[j] = cur.xf[j]; }
        if constexpr (MODE >= 1) {
            f32x4 hv[8]; float ss = 0.f;
#pragma unroll
            for (int j = 0; j < 8; ++j) { const v2u hw = cur.hb[j]; hv[j] = (f32x4){bflo(hw.x), bfhi(hw.x), bflo(hw.y), bfhi(hw.y)}; ss += (hv[j].x * hv[j].x + hv[j].y * hv[j].y) + (hv[j].z * hv[j].z + hv[j].w * hv[j].w); }
            const float rs = sc * __frsqrt_rn(wave_sum(ss) * (1.0f / D) + EPS);
#pragma unroll
            for (int j = 0; j < 8; ++j) xv[j] = xv[j] + hv[j] * gp[j] * rs;
            if constexpr (XD_BF) { v2u* xo = (v2u*)((bf16*)xdst_ + (size_t)m * D) + lane;
#pragma unroll
                for (int j = 0; j < 8; ++j) { v2u w; w.x = pk2(xv[j].x, xv[j].y); w.y = pk2(xv[j].z, xv[j].w); __builtin_nontemporal_store(w, xo + 64 * j); } }
            else { f32x4* xo = (f32x4*)((float*)xdst_ + (size_t)m * D) + lane;
#pragma unroll
                for (int j = 0; j < 8; ++j) __builtin_nontemporal_store(xv[j], xo + 64 * j); }
        }
        if constexpr (MODE != 2) {
            float ss = 0.f;
#pragma unroll
            for (int j = 0; j < 8; ++j) ss += (xv[j].x * xv[j].x + xv[j].y * xv[j].y) + (xv[j].z * xv[j].z + xv[j].w * xv[j].w);
            const float rs = __frsqrt_rn(wave_sum(ss) * (1.0f / D) + EPS);
            v2u* o8 = (v2u*)(xn + (size_t)m * D) + lane;
#pragma unroll
            for (int j = 0; j < 8; ++j) { const f32x4 g = gq[j]; v2u w; w.x = pk2(xv[j].x * rs * g.x, xv[j].y * rs * g.y); w.y = pk2(xv[j].z * rs * g.z, xv[j].w * rs * g.w); o8[64 * j] = w; }
        }
        cur = nxt;
    }
#undef ROW_LOAD
}

#define XB_TMO      128
#define XB_XCNT(j)  (256  + 64 * (j))
#define XB_XSUB(j)  (1280 + 64 * (j))
#define XB_XGEN(j)  (2304 + 64 * (j))
#define XB_TOP      3328
#define XB_TOPGEN   3392
#define XCD_BAR_WORDS 3456
#define XB_SPIN_CAP (1u << 18)

__device__ __forceinline__ unsigned xb_ld(unsigned* p)              { return __hip_atomic_load(p, __ATOMIC_RELAXED, __HIP_MEMORY_SCOPE_AGENT); }
__device__ __forceinline__ unsigned xb_add(unsigned* p, unsigned v) { return __hip_atomic_fetch_add(p, v, __ATOMIC_RELAXED, __HIP_MEMORY_SCOPE_AGENT); }
__device__ __forceinline__ unsigned xb_xcc_id() { return (unsigned)__builtin_amdgcn_s_getreg((3 << 11) | 20) & 0xFu; }
#define XB_SPIN(cond, bar) do { unsigned _sp = 0; while (cond) { __builtin_amdgcn_s_sleep(1); \
    if ((++_sp & 255u) == 0u) { if (xb_ld(&(bar)[XB_TMO])) break; if (_sp > XB_SPIN_CAP) { atomicAdd(&(bar)[XB_TMO], 1u); break; } } } } while (0)

struct XcdBarrier {
    unsigned* bar; unsigned x;
    volatile LAS unsigned* st;
};

__device__ __forceinline__ XcdBarrier xcd_barrier_post(unsigned* bar, volatile LAS unsigned* st) {
    XcdBarrier b; b.bar = bar; b.x = xb_xcc_id(); b.st = st;
    if (threadIdx.x == 0) (void)xb_add(&bar[XB_XCNT(b.x)], 1u);
    return b;
}
__device__ __forceinline__ void xcd_barrier_complete(unsigned* bar, unsigned x, unsigned& nloc, unsigned& nx) {
    const unsigned G = gridDim.x * gridDim.y * gridDim.z;
    unsigned sum, cnt, mine, sp = 0u;
    for (;;) {
        sum = 0u; cnt = 0u; mine = 0u;
#pragma unroll
        for (unsigned j = 0; j < 16; ++j) { const unsigned c = xb_ld(&bar[XB_XCNT(j)]); sum += c; cnt += (c > 0u) ? 1u : 0u; mine = (j == x) ? c : mine; }
        if (sum == G) break;
        __builtin_amdgcn_s_sleep(1);
        if ((++sp & 255u) == 0u) { if (xb_ld(&bar[XB_TMO])) break; if (sp > XB_SPIN_CAP) { atomicAdd(&bar[XB_TMO], 1u); break; } }
    }
    nloc = mine > 0u ? mine : 1u; nx = cnt > 0u ? cnt : 1u;
}

__device__ __forceinline__ void xcd_barrier(const XcdBarrier& b) {
    asm volatile("s_waitcnt vmcnt(0)" ::: "memory");
    __syncthreads();
    if (threadIdx.x == 0) {
        unsigned* bar = b.bar;
        __builtin_amdgcn_s_waitcnt(0);
        unsigned nloc = b.st[0], nx = b.st[1];
        if (nloc == 0u) { xcd_barrier_complete(bar, b.x, nloc, nx); b.st[0] = nloc; b.st[1] = nx; }
        const unsigned old = xb_add(&bar[XB_XSUB(b.x)], 1u);
        const unsigned gen = old / nloc;
        if (old + 1u == (gen + 1u) * nloc) {
            __builtin_amdgcn_fence(__ATOMIC_RELEASE, "agent");
            asm volatile("s_waitcnt vmcnt(0)" ::: "memory");
            const unsigned og = xb_add(&bar[XB_TOP], 1u);
            const unsigned tg = og / nx;
            if (og + 1u == (tg + 1u) * nx) xb_add(&bar[XB_TOPGEN], 1u);
            else XB_SPIN(xb_ld(&bar[XB_TOPGEN]) == tg, bar);
            __builtin_amdgcn_fence(__ATOMIC_ACQUIRE, "agent");
            xb_add(&bar[XB_XGEN(b.x)], 1u);
            asm volatile("s_waitcnt vmcnt(0)" ::: "memory");
        } else {
            XB_SPIN(xb_ld(&bar[XB_XGEN(b.x)]) == gen, bar);
            __builtin_amdgcn_fence(__ATOMIC_ACQUIRE, "agent");
            asm volatile("s_waitcnt vmcnt(0)" ::: "memory");
        }
    }
    __syncthreads();
}

constexpr size_t WS_BAR = 512 * 1024;
struct Args { const float* in[24]; float* out; unsigned char* ws; };

__global__ void __launch_bounds__(512, 2) fwd_mega(Args a) {
    extern __shared__ __attribute__((aligned(16))) unsigned char lds_raw[];
    LAS unsigned char* lds = (LAS unsigned char*)lds_raw;
    const int wave = __builtin_amdgcn_readfirstlane((int)threadIdx.x >> 6);
    const int G = gridDim.x, bx = blockIdx.x;
    const int gw = bx * 8 + wave, NGW = G * 8, NT = G * 512;

    unsigned char* ws = a.ws;
    float* const out = a.out;
    float* const VSS = (float*)(ws + WS_VSS);
    bf16* const WGU1 = (bf16*)(ws + WS_WGU1); bf16* const WD1 = (bf16*)(ws + WS_WD1); bf16* const WGU2 = (bf16*)(ws + WS_WGU2); bf16* const WD2 = (bf16*)(ws + WS_WD2);
    bf16* const WIN = (bf16*)(ws + WS_WIN); bf16* const WOUT = (bf16*)(ws + WS_WOUT); bf16* const WSP = (bf16*)(ws + WS_WSP);
    bf16* const HB = (bf16*)(ws + WS_HB); bf16* const XN = (bf16*)(ws + WS_XN); bf16* const YCAT = (bf16*)(ws + WS_YCAT);
    bf16* const GU = (bf16*)(ws + WS_GU); bf16* const GV = (bf16*)(ws + WS_GV); bf16* const ZB = (bf16*)(ws + WS_Z); bf16* const XBC = (bf16*)(ws + WS_XBC);
    float* const DTRAW = (float*)(ws + WS_DTRAW); float* const DT = (float*)(ws + WS_DT); float* const ACS = (float*)(ws + WS_ACS);
    bf16* const BMm = (bf16*)(ws + WS_BM); bf16* const CMm = (bf16*)(ws + WS_CM); bf16* const XS = (bf16*)(ws + WS_XS); bf16* const XDTT = (bf16*)(ws + WS_XDTT);
    float* const ST = (float*)(ws + WS_ST); bf16* const PREV = (bf16*)(ws + WS_PREV);
    bf16* const X1 = (bf16*)out; bf16* const X2 = (bf16*)(ws + WS_XS); bf16* const HF1 = (bf16*)(ws + WS_XN); bf16* const HF2 = (bf16*)(ws + WS_HF2); bf16* const HF3 = (bf16*)(ws + WS_XN);

    unsigned* const barw = (unsigned*)(ws + WS_BAR);
    volatile LAS unsigned* xst = (volatile LAS unsigned*)(lds + LDS_BYTES - 64);
    if (threadIdx.x < 4) xst[threadIdx.x] = 0u;
    __syncthreads();
    const XcdBarrier xb = xcd_barrier_post(barw, xst);
#define GRID_SYNC() xcd_barrier(xb)
    constexpr int I_GU = (D / 128) * (FF / 64), I_IN = (D / 128) * (NIN / 64), I_OUT = (D / 128) * (D / 64), I_DN = (FF / 128) * (D / 64);
    constexpr int NITEMS = 4 * I_GU + I_IN + I_OUT + 2 * I_DN;
#define CONVERT_ONE(IT) do { int r = (IT); \
            if (r < I_GU) { transpose_seg(a.in[3], FF, D, FF / 64, WGU1, 1, r, scr, lane); break; } r -= I_GU; \
            if (r < I_GU) { transpose_seg(a.in[4], FF, D, FF / 64, WGU1, 2, r, scr, lane); break; } r -= I_GU; \
            if (r < I_DN) { transpose_seg(a.in[5], D, FF, D / 64, WD1, 0, r, scr, lane); break; } r -= I_DN; \
            if (r < I_IN) { transpose_seg(a.in[8], NINF, D, NIN / 64, WIN, 0, r, scr, lane); break; } r -= I_IN; \
            if (r < I_OUT) { transpose_seg(a.in[18], D, D, D / 64, WOUT, 0, r, scr, lane); break; } r -= I_OUT; \
            if (r < I_GU) { transpose_seg(a.in[21], FF, D, FF / 64, WGU2, 1, r, scr, lane); break; } r -= I_GU; \
            if (r < I_GU) { transpose_seg(a.in[22], FF, D, FF / 64, WGU2, 2, r, scr, lane); break; } r -= I_GU; \
            transpose_seg(a.in[23], D, FF, D / 64, WD2, 0, r, scr, lane); } while (0)
#define CONVERT_ITEMS(LO, HI) do { LAS unsigned* scr = (LAS unsigned*)(lds + wave * 16896); \
        for (int it = (LO) + gw; it < (HI); it += NGW) CONVERT_ONE(it); } while (0)
#define CONVERT_STEAL(CNT, LO, HI) do { LAS unsigned* scr = (LAS unsigned*)(lds + wave * 16896); \
        for (;;) { int it = 0; if (lane == 0) it = (int)__hip_atomic_fetch_add((CNT), 1u, __ATOMIC_RELAXED, __HIP_MEMORY_SCOPE_AGENT); \
            it = __builtin_amdgcn_readfirstlane(it) + (LO); if (it >= (HI)) break; CONVERT_ONE(it); } } while (0)
    constexpr int IT_P1B = 2 * I_GU, IT_P3T = 2 * I_GU + I_DN + I_IN + I_OUT;
    {
        int tid = threadIdx.x; asm volatile("" : "+v"(tid)); const int lane = tid & 63, fr = lane & 15, fq = lane >> 4, gt = bx * 512 + tid; (void)fr; (void)fq; (void)gt;
        CONVERT_ITEMS(0, 2 * I_GU);
        for (int i = gt; i < 16 * D; i += NT) { const int j = i / D, k = i % D; WIN[(size_t)(NIN + j) * D + k] = f2bf1(a.in[8][(size_t)k * NINF + NIN + j]); }
        for (int i = gt; i < 8 * 128 * 128; i += NT) { const int t = (i >> 7) & 127, s = i & 127; WSP[i] = s <= t ? f2bf1(a.in[10][i]) : (unsigned short)0; }
        for (int i = gt; i < M; i += NT) VSS[i] = 0.f;
        row_pass<0, false, false>(gw, NGW, lane, nullptr, a.in[0], nullptr, 0.f, nullptr, a.in[1], XN);
    }
    GRID_SYNC();
    { pg8::Gemm g{XN, WGU1, M, NGU, D}; pg8::StaticOrder S; S.init(M, NGU, G, bx); pg8::EpiSwiGLU E{HB, FF};
      pg8::gemm_phase<pg8::EpiSwiGLU, pg8::StaticOrder, true, true>(lds, g, S, E); }
    {
        int tid = threadIdx.x; asm volatile("" : "+v"(tid)); const int lane = tid & 63, fr = lane & 15, fq = lane >> 4, gt = bx * 512 + tid; (void)fr; (void)fq; (void)gt;
        CONVERT_STEAL(barw + 3584, IT_P1B, IT_P3T);
    }
    GRID_SYNC();
    { pg8::Gemm g{HB, WD1, M, D, FF}; pg8::StaticOrder S; S.init(M, D, G, bx); pg8::EpiBf16P E{HF1, D};
      pg8::gemm_phase<pg8::EpiBf16P, pg8::StaticOrder, true, true>(lds, g, S, E); }
    GRID_SYNC();
    {
        int tid = threadIdx.x; asm volatile("" : "+v"(tid)); const int lane = tid & 63, fr = lane & 15, fq = lane >> 4, gt = bx * 512 + tid; (void)fr; (void)fq; (void)gt;
        row_pass<1, false, true>(gw, NGW, lane, HF1, a.in[0], X1, 0.5f, a.in[2], a.in[6], XN);
    }
    GRID_SYNC();
    { pg8::Gemm g{XN, WIN, M, NIN, D}; pg8::StaticOrder S; S.init(M, NIN, G, bx); pg8::EpiInProj E{GU, GV, ZB, XBC, VSS};
      pg8::gemm_phase<pg8::EpiInProj, pg8::StaticOrder, true, true>(lds, g, S, E); }
    {
        int tid = threadIdx.x; asm volatile("" : "+v"(tid)); const int lane = tid & 63;
        CONVERT_STEAL(barw + 3648, IT_P3T, NITEMS);
    }
    {
        int tid = threadIdx.x; asm volatile("" : "+v"(tid)); const int lane = tid & 63, fr = lane & 15, fq = lane >> 4, gt = bx * 512 + tid; (void)fr; (void)fq; (void)gt;
    for (int it = gw; it < M / 16; it += NGW) {
        const int r0 = it * 16; f32x4 acc = {0.f, 0.f, 0.f, 0.f};
        const bf16* wp = WIN + (size_t)(NIN + fr) * D + fq * 8; const bf16* xp = XN + (size_t)(r0 + fr) * D + fq * 8;
#pragma unroll 8
        for (int ks = 0; ks < D / 32; ++ks) { const bf16x8 wa = *(const bf16x8*)(wp + 32 * ks), xb = *(const bf16x8*)(xp + 32 * ks); acc = MFMA16(wa, xb, acc); }
        *(f32x4*)(DTRAW + (size_t)(r0 + fr) * 16 + 4 * fq) = acc;
    }
    }
    GRID_SYNC();
    {
        int tid = threadIdx.x; asm volatile("" : "+v"(tid)); const int lane = tid & 63, fr = lane & 15, fq = lane >> 4, gt = bx * 512 + tid; (void)fr; (void)fq; (void)gt;
        const float* cw = a.in[12]; const float* cb = a.in[13];
        for (int it = gt; it < (M / 32) * (XBCW / 8); it += NT) {
            const int rb = it / (XBCW / 8), c8 = it % (XBCW / 8), ch = c8 * 8, r0 = rb * 32, t0 = r0 & (SEQ - 1);
            const f32x4 b0 = *(const f32x4*)(cb + ch), b1 = *(const f32x4*)(cb + ch + 4);
            f32x4 w0[4], w1[4];
#pragma unroll
            for (int k = 0; k < 4; ++k) { w0[k] = *(const f32x4*)(cw + k * XBCW + ch); w1[k] = *(const f32x4*)(cw + k * XBCW + ch + 4); }
            const bf16* xp = XBC + (size_t)r0 * XBCW + ch;
            v4u h3 = {0u, 0u, 0u, 0u}, h2 = h3, h1 = h3;
            if (t0 != 0) { h3 = *(const v4u*)(xp - 3 * XBCW); h2 = *(const v4u*)(xp - 2 * XBCW); h1 = *(const v4u*)(xp - XBCW); }
            float p3[8] = {bflo(h3.x), bfhi(h3.x), bflo(h3.y), bfhi(h3.y), bflo(h3.z), bfhi(h3.z), bflo(h3.w), bfhi(h3.w)};
            float p2[8] = {bflo(h2.x), bfhi(h2.x), bflo(h2.y), bfhi(h2.y), bflo(h2.z), bfhi(h2.z), bflo(h2.w), bfhi(h2.w)};
            float p1[8] = {bflo(h1.x), bfhi(h1.x), bflo(h1.y), bfhi(h1.y), bflo(h1.z), bfhi(h1.z), bflo(h1.w), bfhi(h1.w)};
            bf16* dst = ch < 1024 ? XS + (size_t)r0 * 1024 + ch : (ch < 1280 ? BMm + (size_t)r0 * 256 + (ch - 1024) : CMm + (size_t)r0 * 256 + (ch - 1280));
            const int dld = ch < 1024 ? 1024 : 256;
#pragma unroll 1
            for (int q = 0; q < 4; ++q) {
                v4u xr[8];
#pragma unroll
                for (int j = 0; j < 8; ++j) xr[j] = *(const v4u*)(xp + (size_t)(8 * q + j) * XBCW);
#pragma unroll
                for (int j = 0; j < 8; ++j) {
                    const float c0[8] = {bflo(xr[j].x), bfhi(xr[j].x), bflo(xr[j].y), bfhi(xr[j].y), bflo(xr[j].z), bfhi(xr[j].z), bflo(xr[j].w), bfhi(xr[j].w)};
                    float y[8];
                    y[0] = b0.x + w0[0].x * p3[0] + w0[1].x * p2[0] + w0[2].x * p1[0] + w0[3].x * c0[0];
                    y[1] = b0.y + w0[0].y * p3[1] + w0[1].y * p2[1] + w0[2].y * p1[1] + w0[3].y * c0[1];
                    y[2] = b0.z + w0[0].z * p3[2] + w0[1].z * p2[2] + w0[2].z * p1[2] + w0[3].z * c0[2];
                    y[3] = b0.w + w0[0].w * p3[3] + w0[1].w * p2[3] + w0[2].w * p1[3] + w0[3].w * c0[3];
                    y[4] = b1.x + w1[0].x * p3[4] + w1[1].x * p2[4] + w1[2].x * p1[4] + w1[3].x * c0[4];
                    y[5] = b1.y + w1[0].y * p3[5] + w1[1].y * p2[5] + w1[2].y * p1[5] + w1[3].y * c0[5];
                    y[6] = b1.z + w1[0].z * p3[6] + w1[1].z * p2[6] + w1[2].z * p1[6] + w1[3].z * c0[6];
                    y[7] = b1.w + w1[0].w * p3[7] + w1[1].w * p2[7] + w1[2].w * p1[7] + w1[3].w * c0[7];
                    pg8::f32x2 sa = {y[0], y[1]}, sb = {y[2], y[3]}, sc = {y[4], y[5]}, sd = {y[6], y[7]};
                    pg8::silu_pk4(sa, sb, sc, sd);
                    v4u o; o.x = pk2(sa.x, sa.y); o.y = pk2(sb.x, sb.y); o.z = pk2(sc.x, sc.y); o.w = pk2(sd.x, sd.y);
                    *(v4u*)(dst + (size_t)(8 * q + j) * dld) = o;
#pragma unroll
                    for (int e = 0; e < 8; ++e) { p3[e] = p2[e]; p2[e] = p1[e]; p1[e] = c0[e]; }
                }
            }
        }
        for (int i = gt; i < M * 16; i += NT) { const float v = DTRAW[i] + a.in[14][i & 15]; DT[i] = fmaxf(v, 0.f) + log1pf(__expf(-fabsf(v))); }
        LAS unsigned short* vnT = (LAS unsigned short*)lds;
        LAS float* rsv = (LAS float*)(lds + 128 * 136 * 2);
        struct SguIn { v4u raw[4]; float vs[4]; f32x4 g0, g1; bf16x8 wbv[4]; v2u guv[8]; float bsv; };
        const int dc = tid & 15;
#define SGU_LOAD(U, X) do { const int hh_ = (U) & 7, rb_ = ((U) >> 3) * 128; \
            _Pragma("unroll") for (int i = 0; i < 4; ++i) { const int s_ = (tid + 512 * i) >> 4; X.raw[i] = *(const v4u*)(GV + (size_t)(rb_ + s_) * AW + hh_ * 128 + 8 * dc); X.vs[i] = VSS[rb_ + s_]; } \
            X.g0 = *(const f32x4*)(a.in[9] + hh_ * 128 + 8 * dc); X.g1 = *(const f32x4*)(a.in[9] + hh_ * 128 + 8 * dc + 4); \
            const bf16* wsp_ = WSP + (size_t)hh_ * 16384 + (16 * wave + fr) * 128 + 8 * fq; \
            _Pragma("unroll") for (int ks = 0; ks < 4; ++ks) X.wbv[ks] = *(const bf16x8*)(wsp_ + 32 * ks); \
            X.bsv = a.in[11][hh_ * 128 + 16 * wave + fr]; \
            _Pragma("unroll") for (int df = 0; df < 8; ++df) X.guv[df] = *(const v2u*)(GU + (size_t)(rb_ + 16 * wave + fr) * AW + hh_ * 128 + 16 * df + 4 * fq); } while (0)
        SguIn cur{}, nxt{};
        if (bx < 1024) SGU_LOAD(bx, cur);
        for (int u = bx; u < 1024; u += G) {
            const int hh = u & 7, rowbase = (u >> 3) * 128;
            const int row = rowbase + 16 * wave + fr;
#pragma unroll
            for (int i = 0; i < 4; ++i) {
                const int s = (tid + 512 * i) >> 4;
                const float rs = __frsqrt_rn(cur.vs[i] * (1.0f / AW) + EPS);
                LAS unsigned short* dstp = vnT + (8 * dc) * 136 + (s ^ (8 * (dc & 7)));
                dstp[0 * 136] = f2bf1(bflo(cur.raw[i].x) * rs * cur.g0.x); dstp[1 * 136] = f2bf1(bfhi(cur.raw[i].x) * rs * cur.g0.y);
                dstp[2 * 136] = f2bf1(bflo(cur.raw[i].y) * rs * cur.g0.z); dstp[3 * 136] = f2bf1(bfhi(cur.raw[i].y) * rs * cur.g0.w);
                dstp[4 * 136] = f2bf1(bflo(cur.raw[i].z) * rs * cur.g1.x); dstp[5 * 136] = f2bf1(bfhi(cur.raw[i].z) * rs * cur.g1.y);
                dstp[6 * 136] = f2bf1(bflo(cur.raw[i].w) * rs * cur.g1.z); dstp[7 * 136] = f2bf1(bfhi(cur.raw[i].w) * rs * cur.g1.w);
            }
            __syncthreads();
            if (u + G < 1024) SGU_LOAD(u + G, nxt);
            f32x4 acc[8];
#pragma unroll
            for (int df = 0; df < 8; ++df) acc[df] = (f32x4){0.f, 0.f, 0.f, 0.f};
            const int kmax = (wave >> 1) + 1;
#pragma unroll
            for (int ks = 0; ks < 4; ++ks) {
                if (ks < kmax) {
#pragma unroll
                    for (int df = 0; df < 8; ++df) { const bf16x8 va = *(const LAS bf16x8*)(vnT + (16 * df + fr) * 136 + ((32 * ks + 8 * fq) ^ (8 * ((2 * df + (fr >> 3)) & 7)))); acc[df] = MFMA16(va, cur.wbv[ks], acc[df]); }
                }
            }
#pragma unroll
            for (int df = 0; df < 8; ++df) {
                const int col = hh * 128 + 16 * df + 4 * fq;
                v2u o; o.x = pk2(bflo(cur.guv[df].x) * (acc[df][0] + cur.bsv), bfhi(cur.guv[df].x) * (acc[df][1] + cur.bsv)); o.y = pk2(bflo(cur.guv[df].y) * (acc[df][2] + cur.bsv), bfhi(cur.guv[df].y) * (acc[df][3] + cur.bsv));
                *(v2u*)(YCAT + (size_t)row * D + col) = o;
            }
            __syncthreads();
            cur = nxt;
        }
#undef SGU_LOAD
    }
    GRID_SYNC();
    {
        int tid = threadIdx.x; asm volatile("" : "+v"(tid)); const int lane = tid & 63, fr = lane & 15, fq = lane >> 4, gt = bx * 512 + tid; (void)fr; (void)fq; (void)gt;
        LAS float* acsL = (LAS float*)lds;
        LAS float* dtL = (LAS float*)(lds + 1024);
        LAS float* wtot = (LAS float*)(lds + 2048);
        LAS unsigned short* xT = (LAS unsigned short*)(lds + 4096);
        LAS unsigned short* bT = (LAS unsigned short*)(lds + 4096 + 64 * 264 * 2);
        struct P4In { float dtv; v4u rawx[4]; v4u rawb[8]; };
#define P4_LOAD(U, X) do { const int h_ = (U) & 15, rc_ = ((U) >> 4) * 256, g_ = h_ >> 3; \
            X.dtv = tid < 256 ? DT[(size_t)(rc_ + tid) * 16 + h_] : 0.f; \
            _Pragma("unroll") for (int i = 0; i < 4; ++i) { const int q = tid + 512 * i; X.rawx[i] = *(const v4u*)(XS + (size_t)(rc_ + (q >> 3)) * 1024 + h_ * 64 + 8 * (q & 7)); } \
            _Pragma("unroll") for (int i = 0; i < 8; ++i) { const int q = tid + 512 * i; X.rawb[i] = *(const v4u*)(BMm + (size_t)(rc_ + (q >> 4)) * 256 + g_ * 128 + 8 * (q & 15)); } } while (0)
        P4In cur{}, nxt{};
        if (bx < 1024) P4_LOAD(bx, cur);
        for (int u = bx; u < 1024; u += G) {
            const int h = u & 15, bc = u >> 4, g = h >> 3, rowc = bc * 256;
            const float ah = -__expf(a.in[15][h]);
            float v = 0.f; const float dtv = cur.dtv;
            if (tid < 256) {
                v = dtv * ah;
#pragma unroll
                for (int o = 1; o < 64; o <<= 1) { const float t = __shfl_up(v, o); if (lane >= o) v += t; }
                if (lane == 63) wtot[wave] = v;
            }
            __syncthreads();
            if (tid < 256) {
                float add = 0.f;
                for (int w = 0; w < 4; ++w) if (w < wave) add += wtot[w];
                v += add; acsL[tid] = v; dtL[tid] = dtv; ACS[(size_t)(rowc + tid) * 16 + h] = v;
            }
            __syncthreads();
            const float alast = acsL[255];
#pragma unroll
            for (int i = 0; i < 4; ++i) {
                const int q = tid + 512 * i, l = q >> 3, pc = q & 7;
                const v4u raw = cur.rawx[i];
                const float d = dtL[l];
                LAS unsigned short* dstp = xT + (8 * pc) * 264 + (l ^ (8 * pc));
                dstp[0 * 264] = f2bf1(bflo(raw.x) * d); dstp[1 * 264] = f2bf1(bfhi(raw.x) * d); dstp[2 * 264] = f2bf1(bflo(raw.y) * d); dstp[3 * 264] = f2bf1(bfhi(raw.y) * d);
                dstp[4 * 264] = f2bf1(bflo(raw.z) * d); dstp[5 * 264] = f2bf1(bfhi(raw.z) * d); dstp[6 * 264] = f2bf1(bflo(raw.w) * d); dstp[7 * 264] = f2bf1(bfhi(raw.w) * d);
            }
#pragma unroll
            for (int i = 0; i < 8; ++i) {
                const int q = tid + 512 * i, l = q >> 4, nc = q & 15;
                const v4u raw = cur.rawb[i];
                const float d = __expf(alast - acsL[l]);
                LAS unsigned short* dstp = bT + (8 * nc) * 264 + (l ^ (8 * (nc & 7)));
                dstp[0 * 264] = f2bf1(bflo(raw.x) * d); dstp[1 * 264] = f2bf1(bfhi(raw.x) * d); dstp[2 * 264] = f2bf1(bflo(raw.y) * d); dstp[3 * 264] = f2bf1(bfhi(raw.y) * d);
                dstp[4 * 264] = f2bf1(bflo(raw.z) * d); dstp[5 * 264] = f2bf1(bfhi(raw.z) * d); dstp[6 * 264] = f2bf1(bflo(raw.w) * d); dstp[7 * 264] = f2bf1(bfhi(raw.w) * d);
            }
            __syncthreads();
            if (u + G < 1024) P4_LOAD(u + G, nxt);
#pragma unroll
            for (int i = 0; i < 4; ++i) {
                const int q = tid + 512 * i, p = q >> 5, lc = q & 31;
                *(v4u*)(XDTT + (size_t)u * 16384 + p * 256 + 8 * lc) = *(const LAS v4u*)(xT + p * 264 + 8 * (lc ^ ((p >> 3) & 7)));
            }
            f32x4 acc[4];
#pragma unroll
            for (int pf = 0; pf < 4; ++pf) acc[pf] = (f32x4){0.f, 0.f, 0.f, 0.f};
#pragma unroll
            for (int ks = 0; ks < 8; ++ks) {
                const bf16x8 ba = *(const LAS bf16x8*)(bT + (16 * wave + fr) * 264 + ((32 * ks + 8 * fq) ^ (8 * ((2 * wave + (fr >> 3)) & 7))));
#pragma unroll
                for (int pf = 0; pf < 4; ++pf) { const bf16x8 xb = *(const LAS bf16x8*)(xT + (16 * pf + fr) * 264 + ((32 * ks + 8 * fq) ^ (8 * ((2 * pf + (fr >> 3)) & 7)))); acc[pf] = MFMA16(ba, xb, acc[pf]); }
            }
#pragma unroll
            for (int pf = 0; pf < 4; ++pf) *(f32x4*)(ST + (size_t)u * 8192 + (16 * pf + fr) * 128 + 16 * wave + 4 * fq) = acc[pf];
            __syncthreads();
            cur = nxt;
        }
#undef P4_LOAD
    }
    GRID_SYNC();
    {
        int tid = threadIdx.x; asm volatile("" : "+v"(tid)); const int lane = tid & 63, fr = lane & 15, fq = lane >> 4, gt = bx * 512 + tid; (void)fr; (void)fq; (void)gt;
    for (int vi = gt; vi < 131072; vi += NT) {
        const int e2 = vi * 2, n = e2 & 127, p = (e2 >> 7) & 63, h = (e2 >> 13) & 15, b = e2 >> 17;
        typedef float f32x2s __attribute__((ext_vector_type(2)));
        f32x2s carry = {0.f, 0.f};
        const size_t base = (size_t)(b * 32 * 16 + h) * 8192 + p * 128 + n;
#pragma unroll 1
        for (int c0 = 0; c0 < 32; c0 += 8) {
            f32x2s st[8]; float dc[8];
#pragma unroll
            for (int j = 0; j < 8; ++j) { st[j] = *(const f32x2s*)(ST + base + (size_t)(c0 + j) * 131072); dc[j] = ACS[(size_t)(b * SEQ + (c0 + j) * 256 + 255) * 16 + h]; }
#pragma unroll
            for (int j = 0; j < 8; ++j) { *(unsigned*)(PREV + base + (size_t)(c0 + j) * 131072) = pk2(carry.x, carry.y); carry = carry * __expf(dc[j]) + st[j]; }
        }
    }
    }
    GRID_SYNC();
    {
        int tid = threadIdx.x; asm volatile("" : "+v"(tid)); const int lane = tid & 63, fr = lane & 15, fq = lane >> 4, gt = bx * 512 + tid; (void)fr; (void)fq; (void)gt;
        LAS float* CB = (LAS float*)lds;
        LAS float* acsL = (LAS float*)(lds + 64 * 260 * 4);
        LAS float* ssL = (LAS float*)(lds + 64 * 260 * 4 + 8192);
        for (int uu = bx, rnd = 0; uu < 512; uu += G, ++rnd) {
            const int u = (rnd & 1) ? ((uu & ~3) | (3 - (uu & 3))) : uu;
            const int lb = u & 3, g = (u >> 2) & 1, bc = u >> 3, rowc = bc * 256, l0 = lb * 64, S = l0 + 64;
            for (int sf = wave; sf < S / 16; sf += 8) {
                f32x4 cacc[4];
#pragma unroll
                for (int lf = 0; lf < 4; ++lf) cacc[lf] = (f32x4){0.f, 0.f, 0.f, 0.f};
#pragma unroll
                for (int ks = 0; ks < 4; ++ks) {
                    const bf16x8 ba = *(const bf16x8*)(BMm + (size_t)(rowc + 16 * sf + fr) * 256 + g * 128 + 32 * ks + 8 * fq);
#pragma unroll
                    for (int lf = 0; lf < 4; ++lf) { const bf16x8 cbv = *(const bf16x8*)(CMm + (size_t)(rowc + l0 + 16 * lf + fr) * 256 + g * 128 + 32 * ks + 8 * fq); cacc[lf] = MFMA16(ba, cbv, cacc[lf]); }
                }
#pragma unroll
                for (int lf = 0; lf < 4; ++lf) *(LAS f32x4*)(CB + (16 * lf + fr) * 260 + 16 * sf + 4 * fq) = cacc[lf];
            }
#pragma unroll
            for (int i = 0; i < 4; ++i) { const int q = tid + 512 * i, hh = q >> 8, l = q & 255; acsL[q] = ACS[(size_t)(rowc + l) * 16 + g * 8 + hh]; }
            __syncthreads();
            const int hh = wave, h = g * 8 + hh; const size_t uh = (size_t)(bc * 16 + h);
            f32x4 acc[4][4];
#pragma unroll
            for (int pf = 0; pf < 4; ++pf)
#pragma unroll
                for (int lf = 0; lf < 4; ++lf) acc[pf][lf] = (f32x4){0.f, 0.f, 0.f, 0.f};
#pragma unroll
            for (int ks = 0; ks < 4; ++ks) {
                bf16x8 pa[4];
#pragma unroll
                for (int pf = 0; pf < 4; ++pf) pa[pf] = *(const bf16x8*)(PREV + uh * 8192 + (16 * pf + fr) * 128 + 32 * ks + 8 * fq);
#pragma unroll
                for (int lf = 0; lf < 4; ++lf) { const bf16x8 cbv = *(const bf16x8*)(CMm + (size_t)(rowc + l0 + 16 * lf + fr) * 256 + g * 128 + 32 * ks + 8 * fq);
#pragma unroll
                    for (int pf = 0; pf < 4; ++pf) acc[pf][lf] = MFMA16(pa[pf], cbv, acc[pf][lf]); }
            }
            float al[4];
#pragma unroll
            for (int lf = 0; lf < 4; ++lf) { al[lf] = acsL[hh * 256 + l0 + 16 * lf + fr]; const float e = __expf(al[lf]);
#pragma unroll
                for (int pf = 0; pf < 4; ++pf) acc[pf][lf] = acc[pf][lf] * e; }
            bf16x8 xa[4], xnx[4];
#pragma unroll
            for (int pf = 0; pf < 4; ++pf) xnx[pf] = *(const bf16x8*)(XDTT + uh * 16384 + (16 * pf + fr) * 256 + 8 * fq);
            for (int ks = 0; ks < S / 32; ++ks) {
                const int s0 = 32 * ks + 8 * fq;
                const int sn = 32 * (ks + 1 < S / 32 ? ks + 1 : ks) + 8 * fq;
#pragma unroll
                for (int pf = 0; pf < 4; ++pf) { xa[pf] = xnx[pf]; xnx[pf] = *(const bf16x8*)(XDTT + uh * 16384 + (16 * pf + fr) * 256 + sn); }
                const f32x4 as0 = *(const LAS f32x4*)(acsL + hh * 256 + s0), as1 = *(const LAS f32x4*)(acsL + hh * 256 + s0 + 4);
#pragma unroll
                for (int lf = 0; lf < 4; ++lf) {
                    if (32 * ks > l0 + 16 * lf + 15) continue;
                    const int l = l0 + 16 * lf + fr;
                    const f32x4 c0 = *(const LAS f32x4*)(CB + (16 * lf + fr) * 260 + s0), c1 = *(const LAS f32x4*)(CB + (16 * lf + fr) * 260 + s0 + 4);
                    const float a_l = al[lf];
                    typedef float f2_ __attribute__((ext_vector_type(2)));
                    const f2_ al2 = {a_l, a_l};
                    f2_ t0 = (al2 - (f2_){as0.x, as0.y}) * 1.44269504f, t1 = (al2 - (f2_){as0.z, as0.w}) * 1.44269504f, t2 = (al2 - (f2_){as1.x, as1.y}) * 1.44269504f, t3 = (al2 - (f2_){as1.z, as1.w}) * 1.44269504f;
                    f2_ e0, e1, e2, e3;
                    e0.x = __builtin_amdgcn_exp2f(t0.x); e0.y = __builtin_amdgcn_exp2f(t0.y); e1.x = __builtin_amdgcn_exp2f(t1.x); e1.y = __builtin_amdgcn_exp2f(t1.y);
                    e2.x = __builtin_amdgcn_exp2f(t2.x); e2.y = __builtin_amdgcn_exp2f(t2.y); e3.x = __builtin_amdgcn_exp2f(t3.x); e3.y = __builtin_amdgcn_exp2f(t3.y);
                    e0 = e0 * (f2_){c0.x, c0.y}; e1 = e1 * (f2_){c0.z, c0.w}; e2 = e2 * (f2_){c1.x, c1.y}; e3 = e3 * (f2_){c1.z, c1.w};
                    const float m0 = (s0 + 0 <= l) ? e0.x : 0.f, m1 = (s0 + 1 <= l) ? e0.y : 0.f, m2 = (s0 + 2 <= l) ? e1.x : 0.f, m3 = (s0 + 3 <= l) ? e1.y : 0.f;
                    const float m4 = (s0 + 4 <= l) ? e2.x : 0.f, m5 = (s0 + 5 <= l) ? e2.y : 0.f, m6 = (s0 + 6 <= l) ? e3.x : 0.f, m7 = (s0 + 7 <= l) ? e3.y : 0.f;
                    v4u mw; mw.x = pk2(m0, m1); mw.y = pk2(m2, m3); mw.z = pk2(m4, m5); mw.w = pk2(m6, m7);
                    const bf16x8 mb = __builtin_bit_cast(bf16x8, mw);
#pragma unroll
                    for (int pf = 0; pf < 4; ++pf) acc[pf][lf] = MFMA16(xa[pf], mb, acc[pf][lf]);
                }
            }
            const float Dh = a.in[16][h];
            float ssq[4];
#pragma unroll
            for (int lf = 0; lf < 4; ++lf) {
                const size_t row = (size_t)(rowc + l0 + 16 * lf + fr); float s2 = 0.f;
#pragma unroll
                for (int pf = 0; pf < 4; ++pf) {
                    const int chn = h * 64 + 16 * pf + 4 * fq;
                    const v2u xv = *(const v2u*)(XS + row * 1024 + chn), zv = *(const v2u*)(ZB + row * 1024 + chn);
                    f32x4 y = acc[pf][lf];
                    y.x = (y.x + Dh * bflo(xv.x)) * bflo(zv.x); y.y = (y.y + Dh * bfhi(xv.x)) * bfhi(zv.x); y.z = (y.z + Dh * bflo(xv.y)) * bflo(zv.y); y.w = (y.w + Dh * bfhi(xv.y)) * bfhi(zv.y);
                    acc[pf][lf] = y; s2 += (y.x * y.x + y.y * y.y) + (y.z * y.z + y.w * y.w);
                }
                s2 += __shfl_xor(s2, 16); s2 += __shfl_xor(s2, 32); ssq[lf] = s2;
                if (fq == 0) ssL[hh * 64 + 16 * lf + fr] = s2;
            }
            __syncthreads();
#pragma unroll
            for (int lf = 0; lf < 4; ++lf) {
                float tot = 0.f;
#pragma unroll
                for (int w = 0; w < 8; ++w) tot += ssL[w * 64 + 16 * lf + fr];
                const float rs = __frsqrt_rn(tot * (1.0f / 512.0f) + EPS);
                const size_t row = (size_t)(rowc + l0 + 16 * lf + fr);
#pragma unroll
                for (int pf = 0; pf < 4; ++pf) {
                    const int chn = h * 64 + 16 * pf + 4 * fq;
                    const f32x4 gn = *(const f32x4*)(a.in[17] + chn); const f32x4 y = acc[pf][lf];
                    v2u o; o.x = pk2(y.x * rs * gn.x, y.y * rs * gn.y); o.y = pk2(y.z * rs * gn.z, y.w * rs * gn.w);
                    *(v2u*)(YCAT + row * D + 1024 + chn) = o;
                }
            }
            __syncthreads();
        }
    }
    GRID_SYNC();
    { pg8::Gemm g{YCAT, WOUT, M, D, D}; pg8::StaticOrder S; S.init(M, D, G, bx); pg8::EpiBf16P E{HF2, D};
      pg8::gemm_phase<pg8::EpiBf16P, pg8::StaticOrder, true, true>(lds, g, S, E); }
    GRID_SYNC();
    {
        int tid = threadIdx.x; asm volatile("" : "+v"(tid)); const int lane = tid & 63, fr = lane & 15, fq = lane >> 4, gt = bx * 512 + tid; (void)fr; (void)fq; (void)gt;
        row_pass<1, true, true>(gw, NGW, lane, HF2, X1, X2, 1.0f, a.in[7], a.in[19], XN);
    }
    GRID_SYNC();
    { pg8::Gemm g{XN, WGU2, M, NGU, D}; pg8::StaticOrder S; S.init(M, NGU, G, bx); pg8::EpiSwiGLU E{HB, FF};
      pg8::gemm_phase<pg8::EpiSwiGLU, pg8::StaticOrder, true, true>(lds, g, S, E); }
    GRID_SYNC();
    { pg8::Gemm g{HB, WD2, M, D, FF}; pg8::StaticOrder S; S.init(M, D, G, bx); pg8::EpiBf16P E{HF3, D};
      pg8::gemm_phase<pg8::EpiBf16P, pg8::StaticOrder, true, true>(lds, g, S, E); }
    GRID_SYNC();
    {
        int tid = threadIdx.x; asm volatile("" : "+v"(tid)); const int lane = tid & 63, fr = lane & 15, fq = lane >> 4, gt = bx * 512 + tid; (void)fr; (void)fq; (void)gt;
        row_pass<2, true, false>(gw, NGW, lane, HF3, X2, out, 0.5f, a.in[20], nullptr, nullptr);
    }
}

extern "C" void kernel_launch(void* const* d_in, const int* in_sizes, int n_in, void* d_out, int out_size, void* d_ws, size_t ws_size, hipStream_t stream) {
    static int grid = 0;
    if (grid == 0) {
        if (n_in != 24 || out_size != M * D || ws_size < WS_END) { fprintf(stderr, "kernel_launch: unexpected shapes (n_in %d out %d ws %zu)\n", n_in, out_size, ws_size); grid = -1; return; }
        int dev = 0, cus = 0, per_cu = 0;
        hipGetDevice(&dev); hipDeviceGetAttribute(&cus, hipDeviceAttributeMultiprocessorCount, dev);
        if (hipFuncSetAttribute((const void*)fwd_mega, hipFuncAttributeMaxDynamicSharedMemorySize, LDS_BYTES) != hipSuccess) { fprintf(stderr, "kernel_launch: hipFuncSetAttribute failed\n"); grid = -1; return; }
        if (hipOccupancyMaxActiveBlocksPerMultiprocessor(&per_cu, (const void*)fwd_mega, 512, LDS_BYTES) != hipSuccess || per_cu < 1) { fprintf(stderr, "kernel_launch: occupancy query gave %d\n", per_cu); per_cu = 1; }
        (void)hipGetLastError();
        grid = cus * 1;
    }
    if (grid < 0) return;
    Args a{};
    for (int i = 0; i < 24; ++i) a.in[i] = (const float*)d_in[i];
    a.out = (float*)d_out; a.ws = (unsigned char*)d_ws;
    if (hipMemsetAsync((char*)d_ws + WS_BAR, 0, 16384, stream) != hipSuccess) { fprintf(stderr, "kernel_launch: memset failed\n"); return; }
    void* args[] = {&a};
    hipError_t e = hipLaunchCooperativeKernel((const void*)fwd_mega, dim3(grid), dim3(512), args, LDS_BYTES, stream);
    if (e != hipSuccess) fprintf(stderr, "cooperative launch failed: %s (grid %d)\n", hipGetErrorString(e), grid);
}
```

```cpp
#include <hip/hip_runtime.h>
#include <hip/hip_cooperative_groups.h>
#include <cstdio>
namespace cg = cooperative_groups;
namespace pg8 {
#define PG8_LAS __attribute__((address_space(3)))
typedef unsigned short bf16_t;
typedef short bf16x8 __attribute__((ext_vector_type(8)));
typedef float f32x4 __attribute__((ext_vector_type(4)));
typedef unsigned u32x4 __attribute__((ext_vector_type(4)));
constexpr int BM = 256, BK = 64, HALF = 128, HTB = HALF * BK * 2  , STAGE_BYTES = 8 * HTB, NXCD = 8, WGM = 8;

__host__ __device__ __forceinline__ int lds_byte(int r, int c) { const int st = (r >> 4) * 2 + (c >> 5), rr = r & 15, cc = c & 31, ob = rr * 64 + cc * 2; return st * 1024 + (ob ^ (((ob >> 9) & 1) << 5)); }
__host__ __device__ __forceinline__ void stage_rc(int b, int& R, int& C) { const int st = b / 1024, sb = b % 1024, swz = sb ^ (((sb >> 9) & 1) << 5); R = (st >> 1) * 16 + swz / 64; C = (st & 1) * 32 + (swz % 64) / 2; }
__host__ __device__ __forceinline__ int perm32(int rho) { const int n = rho >> 4, i = rho & 15; return 8 * (i >> 2) + 4 * n + (i & 3); }

struct Unit { int pm, pn; };
struct Gemm { const bf16_t* A; const bf16_t* Bt; int M, N, K; };

struct StaticOrder {
    int nM, nN, nwg, G, c;
    __host__ __device__ void init(int M, int N, int G_, int c_) { nM = M / BM; nN = N / BM; nwg = nM * nN; G = G_; c = c_; }
    __host__ __device__ bool next(int i, Unit& u) const {
        const long L = (long)i * G + c; if (L >= nwg) return false;
        int wgid = (int)L; { const int q = nwg / NXCD, r = nwg % NXCD, xcd = wgid % NXCD, off = wgid / NXCD; wgid = (xcd < r ? xcd * (q + 1) : r * (q + 1) + (xcd - r) * q) + off; }
        const int nig = WGM * nN, gid = wgid / nig, fm = gid * WGM, gsz = (nM - fm) < WGM ? (nM - fm) : WGM;
        u.pm = fm + ((wgid % nig) % gsz); u.pn = (wgid % nig) / gsz; return true;
    }
    __device__ __forceinline__ void a_ready(const Unit&) const {}
    __device__ __forceinline__ void done(const Unit&) const {}
};
struct CountedOrder : StaticOrder {
    const unsigned* ready; unsigned need; unsigned* tmo;
    __device__ __forceinline__ void a_ready(const Unit& u) const {
        if (threadIdx.x < 64) {
            const unsigned long long t0 = __builtin_amdgcn_s_memrealtime(); unsigned polls = 0;
            while ((unsigned)__builtin_amdgcn_readfirstlane(__hip_atomic_load(ready + 64 * u.pm, __ATOMIC_RELAXED, __HIP_MEMORY_SCOPE_AGENT)) < need) {
                if ((++polls & 255u) == 0u && __builtin_amdgcn_readfirstlane(__hip_atomic_load(tmo, __ATOMIC_RELAXED, __HIP_MEMORY_SCOPE_AGENT)) != 0u) break;
                if (__builtin_amdgcn_s_memrealtime() - t0 > 2000000ull) {
                    if (threadIdx.x == 0) { unsigned expect = 0u; __hip_atomic_compare_exchange_strong(tmo + 1, &expect, 0x600u | (unsigned)(u.pm & 0xff), __ATOMIC_RELAXED, __ATOMIC_RELAXED, __HIP_MEMORY_SCOPE_AGENT); __hip_atomic_store(tmo, 1u, __ATOMIC_RELAXED, __HIP_MEMORY_SCOPE_AGENT); }
                    break; }
                __builtin_amdgcn_s_sleep(2); }
            __builtin_amdgcn_fence(__ATOMIC_ACQUIRE, "agent");
            asm volatile("s_waitcnt vmcnt(0)" ::: "memory");
        }
#if !defined(BROKEN_HOOK_NO_BARRIER)
        asm volatile("" ::: "memory"); __builtin_amdgcn_s_barrier(); asm volatile("" ::: "memory");
#endif
    }
};

__device__ __forceinline__ unsigned cvt_pk_bf16(float lo, float hi) { unsigned r; asm volatile("v_cvt_pk_bf16_f32 %0, %1, %2" : "=v"(r) : "v"(lo), "v"(hi)); return r; }
typedef float f32x2 __attribute__((ext_vector_type(2)));
__device__ __forceinline__ f32x2 gelu_pk(f32x2 v) {
    const f32x2 av = __builtin_elementwise_abs(v), d = av * 0.2316418882f + 1.0f;
    f32x2 t; t.x = __builtin_amdgcn_rcpf(d.x); t.y = __builtin_amdgcn_rcpf(d.y);
    f32x2 q = t * 0.5307027145f + (-0.7265760135f); q = q * t + 0.7107068705f; q = q * t + (-0.142248368f); q = q * t + 0.127414796f; q = q * t;
    const f32x2 s = (v * v) * (-0.72134752044f);
    f32x2 e; e.x = __builtin_amdgcn_exp2f(s.x); e.y = __builtin_amdgcn_exp2f(s.y);
    const f32x2 m = v * (q * e), r = v - m;
    f32x2 o; o.x = v.x < 0.f ? m.x : r.x; o.y = v.y < 0.f ? m.y : r.y; return o;
}

struct EpiF32 {
    static constexpr bool PERM = false, AFTER_DRAIN = false;
    float* C; int ldc; const float* bias;
    __device__ __forceinline__ void operator()(const f32x4 (&acc)[2][2][4][2], const Unit& u, int wr, int wc, int fr, int fq) const {
        const int row0 = u.pm * BM + wr * 64 + fr, col0 = u.pn * BM + wc * 32 + 4 * fq;
        f32x4 bv[2][2];
#pragma unroll
        for (int bj = 0; bj < 2; ++bj)
#pragma unroll
            for (int n = 0; n < 2; ++n) bv[bj][n] = bias ? *(const f32x4*)(bias + col0 + bj * HALF + n * 16) : (f32x4){0.f, 0.f, 0.f, 0.f};
#pragma unroll
        for (int ai = 0; ai < 2; ++ai)
#pragma unroll
            for (int m = 0; m < 4; ++m) { float* rowp = C + (size_t)(row0 + ai * HALF + m * 16) * ldc + col0;
#pragma unroll
                for (int bj = 0; bj < 2; ++bj)
#pragma unroll
                    for (int n = 0; n < 2; ++n) *(f32x4*)(rowp + bj * HALF + n * 16) = acc[ai][bj][m][n] + bv[bj][n]; }
    }
};
}
namespace pg8 {
__device__ __forceinline__ float silu_f(float g) { return g * __builtin_amdgcn_rcpf(1.0f + __expf(-g)); }
__device__ __forceinline__ void gelu_pk4(f32x2& a, f32x2& b, f32x2& c, f32x2& d) {
    const f32x2 aa = __builtin_elementwise_abs(a), ab = __builtin_elementwise_abs(b), ac = __builtin_elementwise_abs(c), ad = __builtin_elementwise_abs(d);
    const f32x2 da = aa * 0.2316418882f + 1.0f, db = ab * 0.2316418882f + 1.0f, dc = ac * 0.2316418882f + 1.0f, dd = ad * 0.2316418882f + 1.0f;
    f32x2 ta, tb, tc, td;
    ta.x = __builtin_amdgcn_rcpf(da.x); ta.y = __builtin_amdgcn_rcpf(da.y); tb.x = __builtin_amdgcn_rcpf(db.x); tb.y = __builtin_amdgcn_rcpf(db.y);
    tc.x = __builtin_amdgcn_rcpf(dc.x); tc.y = __builtin_amdgcn_rcpf(dc.y); td.x = __builtin_amdgcn_rcpf(dd.x); td.y = __builtin_amdgcn_rcpf(dd.y);
    const f32x2 sa = (a * a) * (-0.72134752044f), sb = (b * b) * (-0.72134752044f), sc = (c * c) * (-0.72134752044f), sd = (d * d) * (-0.72134752044f);
    f32x2 ea, eb, ec, ed;
    ea.x = __builtin_amdgcn_exp2f(sa.x); ea.y = __builtin_amdgcn_exp2f(sa.y); eb.x = __builtin_amdgcn_exp2f(sb.x); eb.y = __builtin_amdgcn_exp2f(sb.y);
    ec.x = __builtin_amdgcn_exp2f(sc.x); ec.y = __builtin_amdgcn_exp2f(sc.y); ed.x = __builtin_amdgcn_exp2f(sd.x); ed.y = __builtin_amdgcn_exp2f(sd.y);
    f32x2 qa = ta * 0.5307027145f + (-0.7265760135f), qb = tb * 0.5307027145f + (-0.7265760135f), qc = tc * 0.5307027145f + (-0.7265760135f), qd = td * 0.5307027145f + (-0.7265760135f);
    qa = qa * ta + 0.7107068705f; qb = qb * tb + 0.7107068705f; qc = qc * tc + 0.7107068705f; qd = qd * td + 0.7107068705f;
    qa = qa * ta + (-0.142248368f); qb = qb * tb + (-0.142248368f); qc = qc * tc + (-0.142248368f); qd = qd * td + (-0.142248368f);
    qa = qa * ta + 0.127414796f; qb = qb * tb + 0.127414796f; qc = qc * tc + 0.127414796f; qd = qd * td + 0.127414796f;
    qa = qa * ta; qb = qb * tb; qc = qc * tc; qd = qd * td;
    const f32x2 ma = a * (qa * ea), mb = b * (qb * eb), mc = c * (qc * ec), md = d * (qd * ed);
    const f32x2 ra = a - ma, rb = b - mb, rc = c - mc, rd = d - md;
    f32x2 oa, ob, oc, od;
    oa.x = a.x < 0.f ? ma.x : ra.x; oa.y = a.y < 0.f ? ma.y : ra.y; ob.x = b.x < 0.f ? mb.x : rb.x; ob.y = b.y < 0.f ? mb.y : rb.y;
    oc.x = c.x < 0.f ? mc.x : rc.x; oc.y = c.y < 0.f ? mc.y : rc.y; od.x = d.x < 0.f ? md.x : rd.x; od.y = d.y < 0.f ? md.y : rd.y;
    a = oa; b = ob; c = oc; d = od;
}
__device__ __forceinline__ void silu_pk4(f32x2& a, f32x2& b, f32x2& c, f32x2& d) {
    const f32x2 ta = a * -1.44269504f, tb = b * -1.44269504f, tc = c * -1.44269504f, td = d * -1.44269504f;
    f32x2 ea, eb, ec, ed;
    ea.x = __builtin_amdgcn_exp2f(ta.x); ea.y = __builtin_amdgcn_exp2f(ta.y); eb.x = __builtin_amdgcn_exp2f(tb.x); eb.y = __builtin_amdgcn_exp2f(tb.y);
    ec.x = __builtin_amdgcn_exp2f(tc.x); ec.y = __builtin_amdgcn_exp2f(tc.y); ed.x = __builtin_amdgcn_exp2f(td.x); ed.y = __builtin_amdgcn_exp2f(td.y);
    ea = ea + 1.0f; eb = eb + 1.0f; ec = ec + 1.0f; ed = ed + 1.0f;
    f32x2 ra, rb, rc, rd;
    ra.x = __builtin_amdgcn_rcpf(ea.x); ra.y = __builtin_amdgcn_rcpf(ea.y); rb.x = __builtin_amdgcn_rcpf(eb.x); rb.y = __builtin_amdgcn_rcpf(eb.y);
    rc.x = __builtin_amdgcn_rcpf(ec.x); rc.y = __builtin_amdgcn_rcpf(ec.y); rd.x = __builtin_amdgcn_rcpf(ed.x); rd.y = __builtin_amdgcn_rcpf(ed.y);
    a = a * ra; b = b * rb; c = c * rc; d = d * rd;
}
struct EpiSwiGLU {
    static constexpr bool PERM = true, AFTER_DRAIN = false;
    bf16_t* O; int ldc;
    __device__ __forceinline__ void operator()(const f32x4 (&acc)[2][2][4][2], const Unit& u, int wr, int wc, int fr, int fq) const {
        const int row0 = u.pm * BM + wr * 64 + fr, col0 = u.pn * 128 + wc * 32 + 8 * fq;
#pragma unroll
        for (int ai = 0; ai < 2; ++ai)
#pragma unroll
            for (int m = 0; m < 4; ++m) {
                bf16_t* rowp = O + (size_t)(row0 + ai * HALF + m * 16) * ldc + col0;
                const f32x4 g0 = acc[ai][0][m][0], g1 = acc[ai][0][m][1], u0 = acc[ai][1][m][0], u1 = acc[ai][1][m][1];
                f32x2 ga = {g0[0], g0[1]}, gb = {g0[2], g0[3]}, gc = {g1[0], g1[1]}, gd = {g1[2], g1[3]};
                f32x2 ta = ga * -1.44269504f, tb = gb * -1.44269504f, tc = gc * -1.44269504f, td = gd * -1.44269504f;
                f32x2 ea, eb, ec, ed;
                ea.x = __builtin_amdgcn_exp2f(ta.x); ea.y = __builtin_amdgcn_exp2f(ta.y); eb.x = __builtin_amdgcn_exp2f(tb.x); eb.y = __builtin_amdgcn_exp2f(tb.y);
                ec.x = __builtin_amdgcn_exp2f(tc.x); ec.y = __builtin_amdgcn_exp2f(tc.y); ed.x = __builtin_amdgcn_exp2f(td.x); ed.y = __builtin_amdgcn_exp2f(td.y);
                ea = ea + 1.0f; eb = eb + 1.0f; ec = ec + 1.0f; ed = ed + 1.0f;
                f32x2 pa = ga * (f32x2){u0[0], u0[1]}, pb = gb * (f32x2){u0[2], u0[3]}, pc = gc * (f32x2){u1[0], u1[1]}, pd = gd * (f32x2){u1[2], u1[3]};
                f32x2 ra, rb, rc, rd;
                ra.x = __builtin_amdgcn_rcpf(ea.x); ra.y = __builtin_amdgcn_rcpf(ea.y); rb.x = __builtin_amdgcn_rcpf(eb.x); rb.y = __builtin_amdgcn_rcpf(eb.y);
                rc.x = __builtin_amdgcn_rcpf(ec.x); rc.y = __builtin_amdgcn_rcpf(ec.y); rd.x = __builtin_amdgcn_rcpf(ed.x); rd.y = __builtin_amdgcn_rcpf(ed.y);
                pa = pa * ra; pb = pb * rb; pc = pc * rc; pd = pd * rd;
                u32x4 w;
                w.x = cvt_pk_bf16(pa.x, pa.y); w.y = cvt_pk_bf16(pb.x, pb.y); w.z = cvt_pk_bf16(pc.x, pc.y); w.w = cvt_pk_bf16(pd.x, pd.y);
                *(u32x4*)rowp = w;
            }
    }
};
struct EpiBf16P {
    static constexpr bool PERM = true, AFTER_DRAIN = false;
    bf16_t* O; int ldc;
    __device__ __forceinline__ void operator()(const f32x4 (&acc)[2][2][4][2], const Unit& u, int wr, int wc, int fr, int fq) const {
        const int row0 = u.pm * BM + wr * 64 + fr, col0 = u.pn * BM + wc * 32 + 8 * fq;
#pragma unroll
        for (int ai = 0; ai < 2; ++ai)
#pragma unroll
            for (int m = 0; m < 4; ++m) { bf16_t* rowp = O + (size_t)(row0 + ai * HALF + m * 16) * ldc + col0;
#pragma unroll
                for (int bj = 0; bj < 2; ++bj) { const f32x4 v0 = acc[ai][bj][m][0], v1 = acc[ai][bj][m][1];
                    u32x4 w; w.x = cvt_pk_bf16(v0[0], v0[1]); w.y = cvt_pk_bf16(v0[2], v0[3]); w.z = cvt_pk_bf16(v1[0], v1[1]); w.w = cvt_pk_bf16(v1[2], v1[3]);
                    *(u32x4*)(rowp + bj * HALF) = w; } }
    }
};
struct EpiHS {
    static constexpr bool PERM = true, AFTER_DRAIN = false;
    bf16_t* O; int ldc; float* HQ;
    __device__ __forceinline__ void operator()(const f32x4 (&acc)[2][2][4][2], const Unit& u, int wr, int wc, int fr, int fq) const {
        const int row0 = u.pm * BM + wr * 64 + fr, col0 = u.pn * BM + wc * 32 + 8 * fq;
#pragma unroll
        for (int ai = 0; ai < 2; ++ai)
#pragma unroll
            for (int m = 0; m < 4; ++m) { bf16_t* rowp = O + (size_t)(row0 + ai * HALF + m * 16) * ldc + col0; float ssq = 0.f;
#pragma unroll
                for (int bj = 0; bj < 2; ++bj) { const f32x4 v0 = acc[ai][bj][m][0], v1 = acc[ai][bj][m][1];
                    ssq += (v0[0] * v0[0] + v0[1] * v0[1]) + (v0[2] * v0[2] + v0[3] * v0[3]) + (v1[0] * v1[0] + v1[1] * v1[1]) + (v1[2] * v1[2] + v1[3] * v1[3]);
                    u32x4 w; w.x = cvt_pk_bf16(v0[0], v0[1]); w.y = cvt_pk_bf16(v0[2], v0[3]); w.z = cvt_pk_bf16(v1[0], v1[1]); w.w = cvt_pk_bf16(v1[2], v1[3]);
                    *(u32x4*)(rowp + bj * HALF) = w; }
                ssq += __shfl_xor(ssq, 16); ssq += __shfl_xor(ssq, 32);
                if (fq == 0) __hip_atomic_fetch_add(HQ + (((u.pm * 2 + wr) * 16 + fr) * 8 + ai * 4 + m), ssq, __ATOMIC_RELAXED, __HIP_MEMORY_SCOPE_AGENT); }
    }
};
struct EpiInProj {
    static constexpr bool PERM = true, AFTER_DRAIN = false;
    bf16_t *GU, *GV, *Z, *XBC; float* vss;
    __device__ __forceinline__ void operator()(const f32x4 (&acc)[2][2][4][2], const Unit& u, int wr, int wc, int fr, int fq) const {
        const int pn = u.pn; const int row0 = u.pm * BM + wr * 64 + fr;
        bf16_t* base; int ldc, colt, mode;
        if (pn < 4) { base = GU; ldc = 1024; colt = pn * 256; mode = 0; }
        else if (pn < 8) { base = GV; ldc = 1024; colt = (pn - 4) * 256; mode = 1; }
        else if (pn < 12) { base = Z; ldc = 1024; colt = (pn - 8) * 256; mode = 2; }
        else { base = XBC; ldc = 1536; colt = (pn - 12) * 256; mode = 3; }
        const int col0 = colt + wc * 32 + 8 * fq;
#pragma unroll
        for (int ai = 0; ai < 2; ++ai)
#pragma unroll
            for (int m = 0; m < 4; ++m) {
                const int row = row0 + ai * HALF + m * 16;
                bf16_t* rowp = base + (size_t)row * ldc + col0; float ssq = 0.f;
#pragma unroll
                for (int bj = 0; bj < 2; ++bj) {
                    f32x4 v0 = acc[ai][bj][m][0], v1 = acc[ai][bj][m][1];
                    if (mode <= 1) {
                        f32x2 a = {v0[0], v0[1]}, b = {v0[2], v0[3]}, c = {v1[0], v1[1]}, d = {v1[2], v1[3]};
                        gelu_pk4(a, b, c, d);
                        v0 = (f32x4){a.x, a.y, b.x, b.y}; v1 = (f32x4){c.x, c.y, d.x, d.y};
                        ssq += (v0[0] * v0[0] + v0[1] * v0[1]) + (v0[2] * v0[2] + v0[3] * v0[3]) + (v1[0] * v1[0] + v1[1] * v1[1]) + (v1[2] * v1[2] + v1[3] * v1[3]);
                    } else if (mode == 2) {
                        f32x2 a = {v0[0], v0[1]}, b = {v0[2], v0[3]}, c = {v1[0], v1[1]}, d = {v1[2], v1[3]};
                        silu_pk4(a, b, c, d);
                        v0 = (f32x4){a.x, a.y, b.x, b.y}; v1 = (f32x4){c.x, c.y, d.x, d.y};
                    }
                    u32x4 w; w.x = cvt_pk_bf16(v0[0], v0[1]); w.y = cvt_pk_bf16(v0[2], v0[3]); w.z = cvt_pk_bf16(v1[0], v1[1]); w.w = cvt_pk_bf16(v1[2], v1[3]);
                    *(u32x4*)(rowp + bj * HALF) = w;
                }
                if (mode == 1) { ssq += __shfl_xor(ssq, 16); ssq += __shfl_xor(ssq, 32); if (fq == 0) unsafeAtomicAdd(vss + row, ssq); }
            }
    }
};
}
namespace pg8 {
template <class Epi, class Sched, bool ALIGN_EPI = false, bool SP2 = false, bool REVK = false>
__device__ __forceinline__ void gemm_phase(PG8_LAS unsigned char* lds, const Gemm g, const Sched& S, const Epi& E) {
    const int tid = threadIdx.x, wid = __builtin_amdgcn_readfirstlane(tid >> 6), lane = tid & 63, wr = wid >> 2, wc = wid & 3, fr = lane & 15, fq = lane >> 4;
    const int K = g.K, nt = K / BK;
    unsigned voffA[2], voffB[2];
#pragma unroll
    for (int i = 0; i < 2; ++i) { int R, C; stage_rc(tid * 16 + i * 8192, R, C); const int Rb = Epi::PERM ? ((R & ~31) + perm32(R & 31)) : R;
        voffA[i] = (unsigned)(R * K + C) * 2u; voffB[i] = (unsigned)(Rb * K + C) * 2u; }
    const long kstep = REVK ? -(long)(BK * 2) : (long)(BK * 2);
    const size_t koff0 = REVK ? (size_t)(nt - 1) * (size_t)(BK * 2) : (size_t)0;
    const size_t hstep = (size_t)HALF * K * 2;
    const size_t tstep = 2 * hstep;
    const unsigned ldsw = (unsigned)wid * 1024u;
    const int aoff = lds_byte(wr * 64 + fr, fq * 8), boff = lds_byte(wc * 32 + fr, fq * 8);
#define PG8_SA(b, h) (((b) * 2 + (h)) * HTB)
#define PG8_SB(b, h) ((4 + (b) * 2 + (h)) * HTB)
#define PG8_STAGE(bufoff, gbase, voff) do { _Pragma("unroll") for (int _i = 0; _i < 2; ++_i) \
        __builtin_amdgcn_global_load_lds((const unsigned*)((const char*)(gbase) + (voff)[_i]), (PG8_LAS unsigned*)(lds + (bufoff) + ldsw + _i * 8192), 16, 0, 0); } while (0)
#define PG8_LDA(dst, b, h) do { _Pragma("unroll") for (int m = 0; m < 4; ++m) _Pragma("unroll") for (int k = 0; k < 2; ++k) dst[m][k] = *(const PG8_LAS bf16x8*)(lds + PG8_SA(b, h) + aoff + m * 2048 + k * 1024); } while (0)
#define PG8_LDB(dst, b, h) do { _Pragma("unroll") for (int n = 0; n < 2; ++n) _Pragma("unroll") for (int k = 0; k < 2; ++k) dst[n][k] = *(const PG8_LAS bf16x8*)(lds + PG8_SB(b, h) + boff + n * 2048 + k * 1024); } while (0)
#define PG8_MMA(ai, bj, At, Bt) do { __builtin_amdgcn_s_setprio(1); _Pragma("unroll") for (int k = 0; k < 2; ++k) _Pragma("unroll") for (int m = 0; m < 4; ++m) _Pragma("unroll") for (int n = 0; n < 2; ++n) \
        acc[ai][bj][m][n] = __builtin_amdgcn_mfma_f32_16x16x32_bf16(Bt[n][k], At[m][k], acc[ai][bj][m][n], 0, 0, 0); __builtin_amdgcn_s_setprio(0); } while (0)
#define PG8_WAIT_V(n) asm volatile("s_waitcnt vmcnt(" #n ")" ::: "memory")
#define PG8_WAIT_L(n) asm volatile("s_waitcnt lgkmcnt(" #n ")" ::: "memory")
#define PG8_BAR __builtin_amdgcn_s_barrier()
#define PG8_SCHED __builtin_amdgcn_sched_barrier(0)
    Unit cur, nxt; int ui = 0;
    if (!S.next(0, cur)) return;
    f32x4 acc[2][2][4][2];
#pragma unroll
    for (int a = 0; a < 2; ++a)
#pragma unroll
        for (int b = 0; b < 2; ++b)
#pragma unroll
            for (int m = 0; m < 4; ++m)
#pragma unroll
                for (int n = 0; n < 2; ++n) acc[a][b][m][n] = (f32x4){0.f, 0.f, 0.f, 0.f};
    bf16x8 At[4][2], B0[2][2], B1[2][2];
    const char* cA = (const char*)g.A + (size_t)cur.pm * tstep + koff0; const char* cB = (const char*)g.Bt + (size_t)cur.pn * tstep + koff0;
    S.a_ready(cur);
    if constexpr (SP2) {
        PG8_STAGE(PG8_SB(0, 0), cB, voffB); PG8_STAGE(PG8_SB(0, 1), cB + hstep, voffB); PG8_STAGE(PG8_SA(0, 0), cA, voffA); PG8_STAGE(PG8_SA(0, 1), cA + hstep, voffA);
        if (wr == 1) PG8_BAR;
        PG8_WAIT_V(2); PG8_BAR;
        PG8_STAGE(PG8_SB(1, 0), cB + kstep, voffB); PG8_STAGE(PG8_SA(1, 0), cA + kstep, voffA); PG8_STAGE(PG8_SB(1, 1), cB + hstep + kstep, voffB);
        PG8_WAIT_V(6); PG8_BAR;
    } else {
        PG8_STAGE(PG8_SB(0, 0), cB, voffB); PG8_STAGE(PG8_SA(0, 0), cA, voffA); PG8_STAGE(PG8_SB(0, 1), cB + hstep, voffB); PG8_STAGE(PG8_SA(0, 1), cA + hstep, voffA);
        if (wr == 1) PG8_BAR;
        PG8_WAIT_V(4); PG8_BAR;
        PG8_STAGE(PG8_SB(1, 0), cB + kstep, voffB); PG8_STAGE(PG8_SA(1, 0), cA + kstep, voffA); PG8_STAGE(PG8_SB(1, 1), cB + hstep + kstep, voffB);
        PG8_WAIT_V(6); PG8_BAR;
    }
    for (;;) {
        const bool has_next = S.next(ui + 1, nxt);
        const char* nA = has_next ? (const char*)g.A + (size_t)nxt.pm * tstep + koff0 : cA; const char* nB = has_next ? (const char*)g.Bt + (size_t)nxt.pn * tstep + koff0 : cB;
        for (int t = 0; t < nt; t += 2) {
            const bool last = (t == nt - 2);
            const char* a1 = cA + (long)(t + 1) * kstep;
            const char* a2 = last ? nA : cA + (long)(t + 2) * kstep; const char* b2 = last ? nB : cB + (long)(t + 2) * kstep;
            const char* a3 = a2 + kstep; const char* b3 = b2 + kstep;
            if (last && has_next) S.a_ready(nxt);
            if constexpr (SP2) {
            PG8_LDB(B0, 0, 0); PG8_LDB(B1, 0, 1); PG8_SCHED; PG8_LDA(At, 0, 0); PG8_STAGE(PG8_SA(1, 1), a1 + hstep, voffA);
            PG8_WAIT_V(8); PG8_WAIT_L(0); PG8_BAR; PG8_MMA(0, 0, At, B0); PG8_MMA(0, 1, At, B1); PG8_BAR; PG8_SCHED;
            PG8_LDA(At, 0, 1); PG8_STAGE(PG8_SB(0, 0), b2, voffB); PG8_STAGE(PG8_SB(0, 1), b2 + hstep, voffB); PG8_STAGE(PG8_SA(0, 0), a2, voffA);
            PG8_WAIT_V(8); PG8_WAIT_L(0); PG8_BAR; PG8_MMA(1, 0, At, B0); PG8_MMA(1, 1, At, B1); PG8_BAR; PG8_SCHED;
            PG8_LDB(B0, 1, 0); PG8_LDB(B1, 1, 1); PG8_SCHED; PG8_LDA(At, 1, 0); PG8_STAGE(PG8_SA(0, 1), a2 + hstep, voffA);
            PG8_WAIT_V(8); PG8_WAIT_L(0); PG8_BAR; PG8_MMA(0, 0, At, B0); PG8_MMA(0, 1, At, B1); PG8_BAR; PG8_SCHED;
            PG8_LDA(At, 1, 1); PG8_STAGE(PG8_SB(1, 0), b3, voffB); PG8_STAGE(PG8_SB(1, 1), b3 + hstep, voffB); PG8_STAGE(PG8_SA(1, 0), a3, voffA);
            PG8_WAIT_V(8); PG8_WAIT_L(0); PG8_BAR; PG8_MMA(1, 0, At, B0); PG8_MMA(1, 1, At, B1); PG8_BAR; PG8_SCHED;
            } else {
            PG8_LDB(B0, 0, 0); PG8_SCHED; PG8_LDA(At, 0, 0); PG8_STAGE(PG8_SA(1, 1), a1 + hstep, voffA);
            PG8_WAIT_L(8); PG8_BAR; PG8_WAIT_L(0); PG8_MMA(0, 0, At, B0); PG8_BAR; PG8_SCHED;
            PG8_LDB(B1, 0, 1); PG8_STAGE(PG8_SB(0, 0), b2, voffB);
            PG8_BAR; PG8_WAIT_L(0); PG8_MMA(0, 1, At, B1); PG8_BAR;
            PG8_LDA(At, 0, 1); PG8_STAGE(PG8_SA(0, 0), a2, voffA);
            PG8_BAR; PG8_WAIT_L(0); PG8_MMA(1, 0, At, B0); PG8_BAR; PG8_SCHED;
            PG8_STAGE(PG8_SB(0, 1), b2 + hstep, voffB);
            PG8_WAIT_V(6); PG8_BAR; PG8_MMA(1, 1, At, B1); PG8_BAR;
            PG8_LDB(B0, 1, 0); PG8_SCHED; PG8_LDA(At, 1, 0); PG8_STAGE(PG8_SA(0, 1), a2 + hstep, voffA);
            PG8_WAIT_L(8); PG8_BAR; PG8_WAIT_L(0); PG8_MMA(0, 0, At, B0); PG8_BAR; PG8_SCHED;
            PG8_LDB(B1, 1, 1); PG8_STAGE(PG8_SB(1, 0), b3, voffB);
            PG8_BAR; PG8_WAIT_L(0); PG8_MMA(0, 1, At, B1); PG8_BAR;
            PG8_LDA(At, 1, 1); PG8_STAGE(PG8_SA(1, 0), a3, voffA);
            PG8_BAR; PG8_WAIT_L(0); PG8_MMA(1, 0, At, B0); PG8_BAR; PG8_SCHED;
            PG8_STAGE(PG8_SB(1, 1), b3 + hstep, voffB);
            PG8_WAIT_V(6); PG8_BAR; PG8_MMA(1, 1, At, B1); PG8_BAR;
            }
        }
        if constexpr (ALIGN_EPI) { if (wr == 0) PG8_BAR; }
        if constexpr (!Epi::AFTER_DRAIN) { E(acc, cur, wr, wc, fr, fq); S.done(cur); }
        if (!has_next) break;
#pragma unroll
        for (int a = 0; a < 2; ++a)
#pragma unroll
            for (int b = 0; b < 2; ++b)
#pragma unroll
                for (int m = 0; m < 4; ++m)
#pragma unroll
                    for (int n = 0; n < 2; ++n) acc[a][b][m][n] = (f32x4){0.f, 0.f, 0.f, 0.f};
        cur = nxt; cA = nA; cB = nB; ++ui;
        if constexpr (ALIGN_EPI) { if (wr == 1) PG8_BAR; }
    }
    PG8_WAIT_V(0);
    if constexpr (!ALIGN_EPI) { if (wr == 0) PG8_BAR; }
    PG8_BAR;
    if constexpr (Epi::AFTER_DRAIN) { E.fused(acc, cur, wr, wc, fr, fq, lds, wid, lane); S.done(cur); }
#undef PG8_SA
#undef PG8_SB
#undef PG8_STAGE
#undef PG8_LDA
#undef PG8_LDB
#undef PG8_MMA
#undef PG8_WAIT_V
#undef PG8_WAIT_L
#undef PG8_BAR
#undef PG8_SCHED
}
}
#define LAS __attribute__((address_space(3)))
typedef unsigned short bf16;
typedef unsigned v4u __attribute__((ext_vector_type(4)));
typedef unsigned v2u __attribute__((ext_vector_type(2)));
typedef float f32x4 __attribute__((ext_vector_type(4)));
typedef short bf16x8 __attribute__((ext_vector_type(8)));

constexpr int M = 16384, SEQ = 8192, D = 2048, FF = 5504, NGU = 2 * FF, AW = 1024, NIN = 4608, NINF = 4624, XBCW = 1536;
constexpr float EPS = 1e-6f;
constexpr size_t MiB = 1u << 20;
constexpr size_t WS_VSS = 0;
constexpr size_t WS_WGU1 = 1 * MiB, WS_WD1 = 44 * MiB, WS_WGU2 = 66 * MiB, WS_WD2 = 109 * MiB, WS_WIN = 131 * MiB, WS_WOUT = 150 * MiB, WS_WSP = 158 * MiB;
constexpr size_t WS_HB = 159 * MiB;
constexpr size_t WS_GU = 159 * MiB, WS_GV = 191 * MiB, WS_Z = 223 * MiB, WS_XBC = 255 * MiB, WS_DTRAW = 303 * MiB, WS_DT = 304 * MiB, WS_ACS = 305 * MiB, WS_BM = 306 * MiB, WS_CM = 314 * MiB;
constexpr size_t WS_HF2 = 159 * MiB;
constexpr size_t WS_XN = 331 * MiB;
constexpr size_t WS_YCAT = 331 * MiB;
constexpr size_t WS_XS = 395 * MiB, WS_XDTT = 427 * MiB, WS_ST = 459 * MiB, WS_PREV = 491 * MiB, WS_END = 507 * MiB;
constexpr size_t WS_HF3 = 331 * MiB;
static_assert(WS_HB + (size_t)M * FF * 2 <= WS_XN, "HB");
static_assert(WS_CM + 8 * MiB <= WS_XN, "map");

constexpr int LDS_BYTES = 147456;

__device__ __forceinline__ float bflo(unsigned w) { return __uint_as_float(w << 16); }
__device__ __forceinline__ float bfhi(unsigned w) { return __uint_as_float(w & 0xffff0000u); }
__device__ __forceinline__ unsigned pk2(float lo, float hi) { return pg8::cvt_pk_bf16(lo, hi); }
__device__ __forceinline__ unsigned short f2bf1(float f) { return (unsigned short)(pk2(f, 0.f) & 0xffffu); }
__device__ __forceinline__ float wave_sum(float v) {
#pragma unroll
    for (int o = 1; o < 64; o <<= 1) v += __shfl_xor(v, o);
    return v;
}
__device__ __forceinline__ float silu1(float g) { return g * __builtin_amdgcn_rcpf(1.0f + __expf(-g)); }
#define MFMA16(a, b, c) __builtin_amdgcn_mfma_f32_16x16x32_bf16((a), (b), (c), 0, 0, 0)

__device__ __forceinline__ void transpose_item(const float* W, int ldn, int K, bf16* WT, int k0, int n0, int drow0, LAS unsigned* T, int lane) {
    constexpr int STR = 66;
    const float* wp = W + (size_t)k0 * ldn + n0 + lane;
#pragma unroll
    for (int b = 0; b < 4; ++b) {
        float t[32];
#pragma unroll
        for (int i = 0; i < 32; ++i) t[i] = __builtin_nontemporal_load(wp + (size_t)(32 * b + i) * ldn);
#pragma unroll
        for (int i = 0; i < 16; ++i) T[lane * STR + 16 * b + i] = pk2(t[2 * i], t[2 * i + 1]);
        asm volatile("" ::: "memory");
    }
    asm volatile("s_waitcnt lgkmcnt(0)" ::: "memory");
    const int c = lane & 15, r = lane >> 4;
#pragma unroll
    for (int j = 0; j < 16; ++j) { const int row = 4 * j + r;
        const v2u lo = *(const LAS v2u*)(T + row * STR + 4 * c), hi = *(const LAS v2u*)(T + row * STR + 4 * c + 2);
        v4u o; o.x = lo.x; o.y = lo.y; o.z = hi.x; o.w = hi.y;
        *(v4u*)(WT + (size_t)(drow0 + row) * K + k0 + 8 * c) = o; }
    asm volatile("s_waitcnt lgkmcnt(0)" ::: "memory");
}
__device__ __forceinline__ void transpose_seg(const float* W, int ldn, int K, int nblk, bf16* WT, int mode, int item, LAS unsigned* T, int lane) {
    const int kb = item / nblk, nb = item % nblk, n0 = 64 * nb;
    const int drow0 = mode == 0 ? n0 : (n0 + 128 * (n0 >> 7) + (mode == 2 ? 128 : 0));
    transpose_item(W, ldn, K, WT, 128 * kb, n0, drow0, T, lane);
}

template <int MODE, bool XR_BF, bool XD_BF>
__device__ __forceinline__ void row_pass(int gw, int NGW, int lane, const bf16* hsrc, const void* xres_, void* xdst_, float sc, const float* gpost, const float* gpre, bf16* xn) {
    struct RowIn { f32x4 xf[XR_BF ? 1 : 8]; v2u xb[XR_BF ? 8 : 1]; v2u hb[MODE >= 1 ? 8 : 1]; };
#define ROW_LOAD(MM, R) do { \
        if constexpr (XR_BF) { const v2u* xr_ = (const v2u*)((const bf16*)xres_ + (size_t)(MM) * D) + lane; _Pragma("unroll") for (int j = 0; j < 8; ++j) R.xb[j] = __builtin_nontemporal_load(xr_ + 64 * j); } \
        else { const f32x4* xr_ = (const f32x4*)((const float*)xres_ + (size_t)(MM) * D) + lane; _Pragma("unroll") for (int j = 0; j < 8; ++j) R.xf[j] = __builtin_nontemporal_load(xr_ + 64 * j); } \
        if constexpr (MODE >= 1) { const v2u* hr_ = (const v2u*)(hsrc + (size_t)(MM) * D) + lane; _Pragma("unroll") for (int j = 0; j < 8; ++j) R.hb[j] = __builtin_nontemporal_load(hr_ + 64 * j); } } while (0)
    f32x4 gp[MODE >= 1 ? 8 : 1], gq[MODE != 2 ? 8 : 1];
    if constexpr (MODE >= 1) {
#pragma unroll
        for (int j = 0; j < 8; ++j) gp[j] = ((const f32x4*)gpost)[64 * j + lane]; }
    if constexpr (MODE != 2) {
#pragma unroll
        for (int j = 0; j < 8; ++j) gq[j] = ((const f32x4*)gpre)[64 * j + lane]; }
    RowIn cur{}, nxt{};
    if (gw < M) ROW_LOAD(gw, cur);
    for (int m = gw; m < M; m += NGW) {
        if (m + NGW < M) ROW_LOAD(m + NGW, nxt);
        f32x4 xv[8];
#pragma unroll
        for (int j = 0; j < 8; ++j) { if constexpr (XR_BF) { const v2u w = cur.xb[j]; xv[j] = (f32x4){bflo(w.x), bfhi(w.x), bflo(w.y), bfhi(w.y)}; } else xv[j] = cur.xf[j]; }
        if constexpr (MODE >= 1) {
            f32x4 hv[8]; float ss = 0.f;
#pragma unroll
            for (int j = 0; j < 8; ++j) { const v2u hw = cur.hb[j]; hv[j] = (f32x4){bflo(hw.x), bfhi(hw.x), bflo(hw.y), bfhi(hw.y)}; ss += (hv[j].x * hv[j].x + hv[j].y * hv[j].y) + (hv[j].z * hv[j].z + hv[j].w * hv[j].w); }
            const float rs = sc * __frsqrt_rn(wave_sum(ss) * (1.0f / D) + EPS);
#pragma unroll
            for (int j = 0; j < 8; ++j) xv[j] = xv[j] + hv[j] * gp[j] * rs;
            if constexpr (XD_BF) { v2u* xo = (v2u*)((bf16*)xdst_ + (size_t)m * D) + lane;
#pragma unroll
                for (int j = 0; j < 8; ++j) { v2u w; w.x = pk2(xv[j].x, xv[j].y); w.y = pk2(xv[j].z, xv[j].w); __builtin_nontemporal_store(w, xo + 64 * j); } }
            else { f32x4* xo = (f32x4*)((float*)xdst_ + (size_t)m * D) + lane;
#pragma unroll
                for (int j = 0; j < 8; ++j) __builtin_nontemporal_store(xv[j], xo + 64 * j); }
        }
        if constexpr (MODE != 2) {
            float ss = 0.f;
#pragma unroll
            for (int j = 0; j < 8; ++j) ss += (xv[j].x * xv[j].x + xv[j].y * xv[j].y) + (xv[j].z * xv[j].z + xv[j].w * xv[j].w);
            const float rs = __frsqrt_rn(wave_sum(ss) * (1.0f / D) + EPS);
            v2u* o8 = (v2u*)(xn + (size_t)m * D) + lane;
#pragma unroll
            for (int j = 0; j < 8; ++j) { const f32x4 g = gq[j]; v2u w; w.x = pk2(xv[j].x * rs * g.x, xv[j].y * rs * g.y); w.y = pk2(xv[j].z * rs * g.z, xv[j].w * rs * g.w); o8[64 * j] = w; }
        }
        cur = nxt;
    }
#undef ROW_LOAD
}

#define XB_TMO      128
#define XB_XCNT(j)  (256  + 64 * (j))
#define XB_XSUB(j)  (1280 + 64 * (j))
#define XB_XGEN(j)  (2304 + 64 * (j))
#define XB_TOP      3328
#define XB_TOPGEN   3392
#define XCD_BAR_WORDS 3456
#define XB_SPIN_CAP (1u << 18)

__device__ __forceinline__ unsigned xb_ld(unsigned* p)              { return __hip_atomic_load(p, __ATOMIC_RELAXED, __HIP_MEMORY_SCOPE_AGENT); }
__device__ __forceinline__ unsigned xb_add(unsigned* p, unsigned v) { return __hip_atomic_fetch_add(p, v, __ATOMIC_RELAXED, __HIP_MEMORY_SCOPE_AGENT); }
__device__ __forceinline__ unsigned xb_xcc_id() { return (unsigned)__builtin_amdgcn_s_getreg((3 << 11) | 20) & 0xFu; }
#define XB_SPIN(cond, bar) do { unsigned _sp = 0; while (cond) { __builtin_amdgcn_s_sleep(1); \
    if ((++_sp & 255u) == 0u) { if (xb_ld(&(bar)[XB_TMO])) break; if (_sp > XB_SPIN_CAP) { atomicAdd(&(bar)[XB_TMO], 1u); break; } } } } while (0)

struct XcdBarrier {
    unsigned* bar; unsigned x;
    volatile LAS unsigned* st;
};

__device__ __forceinline__ XcdBarrier xcd_barrier_post(unsigned* bar, volatile LAS unsigned* st) {
    XcdBarrier b; b.bar = bar; b.x = xb_xcc_id(); b.st = st;
    if (threadIdx.x == 0) (void)xb_add(&bar[XB_XCNT(b.x)], 1u);
    return b;
}
__device__ __forceinline__ void xcd_barrier_complete(unsigned* bar, unsigned x, unsigned& nloc, unsigned& nx) {
    const unsigned G = gridDim.x * gridDim.y * gridDim.z;
    unsigned sum, cnt, mine, sp = 0u;
    for (;;) {
        sum = 0u; cnt = 0u; mine = 0u;
#pragma unroll
        for (unsigned j = 0; j < 16; ++j) { const unsigned c = xb_ld(&bar[XB_XCNT(j)]); sum += c; cnt += (c > 0u) ? 1u : 0u; mine = (j == x) ? c : mine; }
        if (sum == G) break;
        __builtin_amdgcn_s_sleep(1);
        if ((++sp & 255u) == 0u) { if (xb_ld(&bar[XB_TMO])) break; if (sp > XB_SPIN_CAP) { atomicAdd(&bar[XB_TMO], 1u); break; } }
    }
    nloc = mine > 0u ? mine : 1u; nx = cnt > 0u ? cnt : 1u;
}

__device__ __forceinline__ void xcd_barrier(const XcdBarrier& b) {
    asm volatile("s_waitcnt vmcnt(0)" ::: "memory");
    __syncthreads();
    if (threadIdx.x == 0) {
        unsigned* bar = b.bar;
        __builtin_amdgcn_s_waitcnt(0);
        unsigned nloc = b.st[0], nx = b.st[1];
        if (nloc == 0u) { xcd_barrier_complete(bar, b.x, nloc, nx); b.st[0] = nloc; b.st[1] = nx; }
        const unsigned old = xb_add(&bar[XB_XSUB(b.x)], 1u);
        const unsigned gen = old / nloc;
        if (old + 1u == (gen + 1u) * nloc) {
            __builtin_amdgcn_fence(__ATOMIC_RELEASE, "agent");
            asm volatile("s_waitcnt vmcnt(0)" ::: "memory");
            const unsigned og = xb_add(&bar[XB_TOP], 1u);
            const unsigned tg = og / nx;
            if (og + 1u == (tg + 1u) * nx) xb_add(&bar[XB_TOPGEN], 1u);
            else XB_SPIN(xb_ld(&bar[XB_TOPGEN]) == tg, bar);
            __builtin_amdgcn_fence(__ATOMIC_ACQUIRE, "agent");
            xb_add(&bar[XB_XGEN(b.x)], 1u);
            asm volatile("s_waitcnt vmcnt(0)" ::: "memory");
        } else {
            XB_SPIN(xb_ld(&bar[XB_XGEN(b.x)]) == gen, bar);
            __builtin_amdgcn_fence(__ATOMIC_ACQUIRE, "agent");
            asm volatile("s_waitcnt vmcnt(0)" ::: "memory");
        }
    }
    __syncthreads();
}

constexpr size_t WS_BAR = 512 * 1024;
struct Args { const float* in[24]; float* out; unsigned char* ws; };

__global__ void __launch_bounds__(512, 2) fwd_mega(Args a) {
    extern __shared__ __attribute__((aligned(16))) unsigned char lds_raw[];
    LAS unsigned char* lds = (LAS unsigned char*)lds_raw;
    const int wave = __builtin_amdgcn_readfirstlane((int)threadIdx.x >> 6);
    const int G = gridDim.x, bx = blockIdx.x;
    const int gw = bx * 8 + wave, NGW = G * 8, NT = G * 512;

    unsigned char* ws = a.ws;
    float* const out = a.out;
    float* const VSS = (float*)(ws + WS_VSS);
    bf16* const WGU1 = (bf16*)(ws + WS_WGU1); bf16* const WD1 = (bf16*)(ws + WS_WD1); bf16* const WGU2 = (bf16*)(ws + WS_WGU2); bf16* const WD2 = (bf16*)(ws + WS_WD2);
    bf16* const WIN = (bf16*)(ws + WS_WIN); bf16* const WOUT = (bf16*)(ws + WS_WOUT); bf16* const WSP = (bf16*)(ws + WS_WSP);
    bf16* const HB = (bf16*)(ws + WS_HB); bf16* const XN = (bf16*)(ws + WS_XN); bf16* const YCAT = (bf16*)(ws + WS_YCAT);
    bf16* const GU = (bf16*)(ws + WS_GU); bf16* const GV = (bf16*)(ws + WS_GV); bf16* const ZB = (bf16*)(ws + WS_Z); bf16* const XBC = (bf16*)(ws + WS_XBC);
    float* const DTRAW = (float*)(ws + WS_DTRAW); float* const DT = (float*)(ws + WS_DT); float* const ACS = (float*)(ws + WS_ACS);
    bf16* const BMm = (bf16*)(ws + WS_BM); bf16* const CMm = (bf16*)(ws + WS_CM); bf16* const XS = (bf16*)(ws + WS_XS); bf16* const XDTT = (bf16*)(ws + WS_XDTT);
    float* const ST = (float*)(ws + WS_ST); bf16* const PREV = (bf16*)(ws + WS_PREV);
    bf16* const X1 = (bf16*)out; bf16* const X2 = (bf16*)(ws + WS_XS); bf16* const HF1 = (bf16*)(ws + WS_XN); bf16* const HF2 = (bf16*)(ws + WS_HF2); bf16* const HF3 = (bf16*)(ws + WS_XN);

    unsigned* const barw = (unsigned*)(ws + WS_BAR);
    volatile LAS unsigned* xst = (volatile LAS unsigned*)(lds + LDS_BYTES - 64);
    if (threadIdx.x < 4) xst[threadIdx.x] = 0u;
    __syncthreads();
    const XcdBarrier xb = xcd_barrier_post(barw, xst);
#define GRID_SYNC() xcd_barrier(xb)
    constexpr int I_GU = (D / 128) * (FF / 64), I_IN = (D / 128) * (NIN / 64), I_OUT = (D / 128) * (D / 64), I_DN = (FF / 128) * (D / 64);
    constexpr int NITEMS = 4 * I_GU + I_IN + I_OUT + 2 * I_DN;
#define CONVERT_ONE(IT) do { int r = (IT); \
            if (r < I_GU) { transpose_seg(a.in[3], FF, D, FF / 64, WGU1, 1, r, scr, lane); break; } r -= I_GU; \
            if (r < I_GU) { transpose_seg(a.in[4], FF, D, FF / 64, WGU1, 2, r, scr, lane); break; } r -= I_GU; \
            if (r < I_DN) { transpose_seg(a.in[5], D, FF, D / 64, WD1, 0, r, scr, lane); break; } r -= I_DN; \
            if (r < I_IN) { transpose_seg(a.in[8], NINF, D, NIN / 64, WIN, 0, r, scr, lane); break; } r -= I_IN; \
            if (r < I_OUT) { transpose_seg(a.in[18], D, D, D / 64, WOUT, 0, r, scr, lane); break; } r -= I_OUT; \
            if (r < I_GU) { transpose_seg(a.in[21], FF, D, FF / 64, WGU2, 1, r, scr, lane); break; } r -= I_GU; \
            if (r < I_GU) { transpose_seg(a.in[22], FF, D, FF / 64, WGU2, 2, r, scr, lane); break; } r -= I_GU; \
            transpose_seg(a.in[23], D, FF, D / 64, WD2, 0, r, scr, lane); } while (0)
#define CONVERT_ITEMS(LO, HI) do { LAS unsigned* scr = (LAS unsigned*)(lds + wave * 16896); \
        for (int it = (LO) + gw; it < (HI); it += NGW) CONVERT_ONE(it); } while (0)
#define CONVERT_STEAL(CNT, LO, HI) do { LAS unsigned* scr = (LAS unsigned*)(lds + wave * 16896); \
        for (;;) { int it = 0; if (lane == 0) it = (int)__hip_atomic_fetch_add((CNT), 1u, __ATOMIC_RELAXED, __HIP_MEMORY_SCOPE_AGENT); \
            it = __builtin_amdgcn_readfirstlane(it) + (LO); if (it >= (HI)) break; CONVERT_ONE(it); } } while (0)
    constexpr int IT_P1B = 2 * I_GU, IT_P3T = 2 * I_GU + I_DN + I_IN + I_OUT;
    {
        int tid = threadIdx.x; asm volatile("" : "+v"(tid)); const int lane = tid & 63, fr = lane & 15, fq = lane >> 4, gt = bx * 512 + tid; (void)fr; (void)fq; (void)gt;
        CONVERT_ITEMS(0, 2 * I_GU);
        for (int i = gt; i < 16 * D; i += NT) { const int j = i / D, k = i % D; WIN[(size_t)(NIN + j) * D + k] = f2bf1(a.in[8][(size_t)k * NINF + NIN + j]); }
        for (int i = gt; i < 8 * 128 * 128; i += NT) { const int t = (i >> 7) & 127, s = i & 127; WSP[i] = s <= t ? f2bf1(a.in[10][i]) : (unsigned short)0; }
        for (int i = gt; i < M; i += NT) VSS[i] = 0.f;
        row_pass<0, false, false>(gw, NGW, lane, nullptr, a.in[0], nullptr, 0.f, nullptr, a.in[1], XN);
    }
    GRID_SYNC();
    { pg8::Gemm g{XN, WGU1, M, NGU, D}; pg8::StaticOrder S; S.init(M, NGU, G, bx); pg8::EpiSwiGLU E{HB, FF};
      pg8::gemm_phase<pg8::EpiSwiGLU, pg8::StaticOrder, true, true>(lds, g, S, E); }
    {
        int tid = threadIdx.x; asm volatile("" : "+v"(tid)); const int lane = tid & 63, fr = lane & 15, fq = lane >> 4, gt = bx * 512 + tid; (void)fr; (void)fq; (void)gt;
        CONVERT_STEAL(barw + 3584, IT_P1B, IT_P3T);
    }
    GRID_SYNC();
    { pg8::Gemm g{HB, WD1, M, D, FF}; pg8::StaticOrder S; S.init(M, D, G, bx); pg8::EpiBf16P E{HF1, D};
      pg8::gemm_phase<pg8::EpiBf16P, pg8::StaticOrder, true, true, true>(lds, g, S, E); }
    GRID_SYNC();
    {
        int tid = threadIdx.x; asm volatile("" : "+v"(tid)); const int lane = tid & 63, fr = lane & 15, fq = lane >> 4, gt = bx * 512 + tid; (void)fr; (void)fq; (void)gt;
        row_pass<1, false, true>(gw, NGW, lane, HF1, a.in[0], X1, 0.5f, a.in[2], a.in[6], XN);
    }
    GRID_SYNC();
    { pg8::Gemm g{XN, WIN, M, NIN, D}; pg8::StaticOrder S; S.init(M, NIN, G, bx); pg8::EpiInProj E{GU, GV, ZB, XBC, VSS};
      pg8::gemm_phase<pg8::EpiInProj, pg8::StaticOrder, true, true>(lds, g, S, E); }
    {
        int tid = threadIdx.x; asm volatile("" : "+v"(tid)); const int lane = tid & 63;
        CONVERT_STEAL(barw + 3648, IT_P3T, NITEMS);
    }
    {
        int tid = threadIdx.x; asm volatile("" : "+v"(tid)); const int lane = tid & 63, fr = lane & 15, fq = lane >> 4, gt = bx * 512 + tid; (void)fr; (void)fq; (void)gt;
    for (int it = gw; it < M / 16; it += NGW) {
        const int r0 = it * 16; f32x4 acc = {0.f, 0.f, 0.f, 0.f};
        const bf16* wp = WIN + (size_t)(NIN + fr) * D + fq * 8; const bf16* xp = XN + (size_t)(r0 + fr) * D + fq * 8;
#pragma unroll 8
        for (int ks = 0; ks < D / 32; ++ks) { const bf16x8 wa = *(const bf16x8*)(wp + 32 * ks), xb = *(const bf16x8*)(xp + 32 * ks); acc = MFMA16(wa, xb, acc); }
        *(f32x4*)(DTRAW + (size_t)(r0 + fr) * 16 + 4 * fq) = acc;
    }
    }
    GRID_SYNC();
    {
        int tid = threadIdx.x; asm volatile("" : "+v"(tid)); const int lane = tid & 63, fr = lane & 15, fq = lane >> 4, gt = bx * 512 + tid; (void)fr; (void)fq; (void)gt;
        const float* cw = a.in[12]; const float* cb = a.in[13];
        for (int it = gt; it < (M / 32) * (XBCW / 8); it += NT) {
            const int rb = it / (XBCW / 8), c8 = it % (XBCW / 8), ch = c8 * 8, r0 = rb * 32, t0 = r0 & (SEQ - 1);
            const f32x4 b0 = *(const f32x4*)(cb + ch), b1 = *(const f32x4*)(cb + ch + 4);
            f32x4 w0[4], w1[4];
#pragma unroll
            for (int k = 0; k < 4; ++k) { w0[k] = *(const f32x4*)(cw + k * XBCW + ch); w1[k] = *(const f32x4*)(cw + k * XBCW + ch + 4); }
            const bf16* xp = XBC + (size_t)r0 * XBCW + ch;
            v4u h3 = {0u, 0u, 0u, 0u}, h2 = h3, h1 = h3;
            if (t0 != 0) { h3 = *(const v4u*)(xp - 3 * XBCW); h2 = *(const v4u*)(xp - 2 * XBCW); h1 = *(const v4u*)(xp - XBCW); }
            float p3[8] = {bflo(h3.x), bfhi(h3.x), bflo(h3.y), bfhi(h3.y), bflo(h3.z), bfhi(h3.z), bflo(h3.w), bfhi(h3.w)};
            float p2[8] = {bflo(h2.x), bfhi(h2.x), bflo(h2.y), bfhi(h2.y), bflo(h2.z), bfhi(h2.z), bflo(h2.w), bfhi(h2.w)};
            float p1[8] = {bflo(h1.x), bfhi(h1.x), bflo(h1.y), bfhi(h1.y), bflo(h1.z), bfhi(h1.z), bflo(h1.w), bfhi(h1.w)};
            bf16* dst = ch < 1024 ? XS + (size_t)r0 * 1024 + ch : (ch < 1280 ? BMm + (size_t)r0 * 256 + (ch - 1024) : CMm + (size_t)r0 * 256 + (ch - 1280));
            const int dld = ch < 1024 ? 1024 : 256;
#pragma unroll 1
            for (int q = 0; q < 4; ++q) {
                v4u xr[8];
#pragma unroll
                for (int j = 0; j < 8; ++j) xr[j] = *(const v4u*)(xp + (size_t)(8 * q + j) * XBCW);
#pragma unroll
                for (int j = 0; j < 8; ++j) {
                    const float c0[8] = {bflo(xr[j].x), bfhi(xr[j].x), bflo(xr[j].y), bfhi(xr[j].y), bflo(xr[j].z), bfhi(xr[j].z), bflo(xr[j].w), bfhi(xr[j].w)};
                    float y[8];
                    y[0] = b0.x + w0[0].x * p3[0] + w0[1].x * p2[0] + w0[2].x * p1[0] + w0[3].x * c0[0];
                    y[1] = b0.y + w0[0].y * p3[1] + w0[1].y * p2[1] + w0[2].y * p1[1] + w0[3].y * c0[1];
                    y[2] = b0.z + w0[0].z * p3[2] + w0[1].z * p2[2] + w0[2].z * p1[2] + w0[3].z * c0[2];
                    y[3] = b0.w + w0[0].w * p3[3] + w0[1].w * p2[3] + w0[2].w * p1[3] + w0[3].w * c0[3];
                    y[4] = b1.x + w1[0].x * p3[4] + w1[1].x * p2[4] + w1[2].x * p1[4] + w1[3].x * c0[4];
                    y[5] = b1.y + w1[0].y * p3[5] + w1[1].y * p2[5] + w1[2].y * p1[5] + w1[3].y * c0[5];
                    y[6] = b1.z + w1[0].z * p3[6] + w1[1].z * p2[6] + w1[2].z * p1[6] + w1[3].z * c0[6];
                    y[7] = b1.w + w1[0].w * p3[7] + w1[1].w * p2[7] + w1[2].w * p1[7] + w1[3].w * c0[7];
                    pg8::f32x2 sa = {y[0], y[1]}, sb = {y[2], y[3]}, sc = {y[4], y[5]}, sd = {y[6], y[7]};
                    pg8::silu_pk4(sa, sb, sc, sd);
                    v4u o; o.x = pk2(sa.x, sa.y); o.y = pk2(sb.x, sb.y); o.z = pk2(sc.x, sc.y); o.w = pk2(sd.x, sd.y);
                    *(v4u*)(dst + (size_t)(8 * q + j) * dld) = o;
#pragma unroll
                    for (int e = 0; e < 8; ++e) { p3[e] = p2[e]; p2[e] = p1[e]; p1[e] = c0[e]; }
                }
            }
        }
        for (int i = gt; i < M * 16; i += NT) { const float v = DTRAW[i] + a.in[14][i & 15]; DT[i] = fmaxf(v, 0.f) + log1pf(__expf(-fabsf(v))); }
        LAS unsigned short* vnT = (LAS unsigned short*)lds;
        LAS float* rsv = (LAS float*)(lds + 128 * 136 * 2);
        struct SguIn { v4u raw[4]; float vs[4]; f32x4 g0, g1; bf16x8 wbv[4]; v2u guv[8]; float bsv; };
        const int dc = tid & 15;
#define SGU_LOAD(U, X) do { const int hh_ = (U) & 7, rb_ = ((U) >> 3) * 128; \
            _Pragma("unroll") for (int i = 0; i < 4; ++i) { const int s_ = (tid + 512 * i) >> 4; X.raw[i] = *(const v4u*)(GV + (size_t)(rb_ + s_) * AW + hh_ * 128 + 8 * dc); X.vs[i] = VSS[rb_ + s_]; } \
            X.g0 = *(const f32x4*)(a.in[9] + hh_ * 128 + 8 * dc); X.g1 = *(const f32x4*)(a.in[9] + hh_ * 128 + 8 * dc + 4); \
            const bf16* wsp_ = WSP + (size_t)hh_ * 16384 + (16 * wave + fr) * 128 + 8 * fq; \
            _Pragma("unroll") for (int ks = 0; ks < 4; ++ks) X.wbv[ks] = *(const bf16x8*)(wsp_ + 32 * ks); \
            X.bsv = a.in[11][hh_ * 128 + 16 * wave + fr]; \
            _Pragma("unroll") for (int df = 0; df < 8; ++df) X.guv[df] = *(const v2u*)(GU + (size_t)(rb_ + 16 * wave + fr) * AW + hh_ * 128 + 16 * df + 4 * fq); } while (0)
        SguIn cur{}, nxt{};
        if (bx < 1024) SGU_LOAD(bx, cur);
        for (int u = bx; u < 1024; u += G) {
            const int hh = u & 7, rowbase = (u >> 3) * 128;
            const int row = rowbase + 16 * wave + fr;
#pragma unroll
            for (int i = 0; i < 4; ++i) {
                const int s = (tid + 512 * i) >> 4;
                const float rs = __frsqrt_rn(cur.vs[i] * (1.0f / AW) + EPS);
                LAS unsigned short* dstp = vnT + (8 * dc) * 136 + (s ^ (8 * (dc & 7)));
                dstp[0 * 136] = f2bf1(bflo(cur.raw[i].x) * rs * cur.g0.x); dstp[1 * 136] = f2bf1(bfhi(cur.raw[i].x) * rs * cur.g0.y);
                dstp[2 * 136] = f2bf1(bflo(cur.raw[i].y) * rs * cur.g0.z); dstp[3 * 136] = f2bf1(bfhi(cur.raw[i].y) * rs * cur.g0.w);
                dstp[4 * 136] = f2bf1(bflo(cur.raw[i].z) * rs * cur.g1.x); dstp[5 * 136] = f2bf1(bfhi(cur.raw[i].z) * rs * cur.g1.y);
                dstp[6 * 136] = f2bf1(bflo(cur.raw[i].w) * rs * cur.g1.z); dstp[7 * 136] = f2bf1(bfhi(cur.raw[i].w) * rs * cur.g1.w);
            }
            __syncthreads();
            if (u + G < 1024) SGU_LOAD(u + G, nxt);
            f32x4 acc[8];
#pragma unroll
            for (int df = 0; df < 8; ++df) acc[df] = (f32x4){0.f, 0.f, 0.f, 0.f};
            const int kmax = (wave >> 1) + 1;
#pragma unroll
            for (int ks = 0; ks < 4; ++ks) {
                if (ks < kmax) {
#pragma unroll
                    for (int df = 0; df < 8; ++df) { const bf16x8 va = *(const LAS bf16x8*)(vnT + (16 * df + fr) * 136 + ((32 * ks + 8 * fq) ^ (8 * ((2 * df + (fr >> 3)) & 7)))); acc[df] = MFMA16(va, cur.wbv[ks], acc[df]); }
                }
            }
#pragma unroll
            for (int df = 0; df < 8; ++df) {
                const int col = hh * 128 + 16 * df + 4 * fq;
                v2u o; o.x = pk2(bflo(cur.guv[df].x) * (acc[df][0] + cur.bsv), bfhi(cur.guv[df].x) * (acc[df][1] + cur.bsv)); o.y = pk2(bflo(cur.guv[df].y) * (acc[df][2] + cur.bsv), bfhi(cur.guv[df].y) * (acc[df][3] + cur.bsv));
                *(v2u*)(YCAT + (size_t)row * D + col) = o;
            }
            __syncthreads();
            cur = nxt;
        }
#undef SGU_LOAD
    }
    GRID_SYNC();
    {
        int tid = threadIdx.x; asm volatile("" : "+v"(tid)); const int lane = tid & 63, fr = lane & 15, fq = lane >> 4, gt = bx * 512 + tid; (void)fr; (void)fq; (void)gt;
        LAS float* acsL = (LAS float*)lds;
        LAS float* dtL = (LAS float*)(lds + 1024);
        LAS float* wtot = (LAS float*)(lds + 2048);
        LAS unsigned short* xT = (LAS unsigned short*)(lds + 4096);
        LAS unsigned short* bT = (LAS unsigned short*)(lds + 4096 + 64 * 264 * 2);
        struct P4In { float dtv; v4u rawx[4]; v4u rawb[8]; };
#define P4_LOAD(U, X) do { const int h_ = (U) & 15, rc_ = ((U) >> 4) * 256, g_ = h_ >> 3; \
            X.dtv = tid < 256 ? DT[(size_t)(rc_ + tid) * 16 + h_] : 0.f; \
            _Pragma("unroll") for (int i = 0; i < 4; ++i) { const int q = tid + 512 * i; X.rawx[i] = *(const v4u*)(XS + (size_t)(rc_ + (q >> 3)) * 1024 + h_ * 64 + 8 * (q & 7)); } \
            _Pragma("unroll") for (int i = 0; i < 8; ++i) { const int q = tid + 512 * i; X.rawb[i] = *(const v4u*)(BMm + (size_t)(rc_ + (q >> 4)) * 256 + g_ * 128 + 8 * (q & 15)); } } while (0)
        P4In cur{}, nxt{};
        if (bx < 1024) P4_LOAD(bx, cur);
        for (int u = bx; u < 1024; u += G) {
            const int h = u & 15, bc = u >> 4, g = h >> 3, rowc = bc * 256;
            const float ah = -__expf(a.in[15][h]);
            float v = 0.f; const float dtv = cur.dtv;
            if (tid < 256) {
                v = dtv * ah;
#pragma unroll
                for (int o = 1; o < 64; o <<= 1) { const float t = __shfl_up(v, o); if (lane >= o) v += t; }
                if (lane == 63) wtot[wave] = v;
            }
            __syncthreads();
            if (tid < 256) {
                float add = 0.f;
                for (int w = 0; w < 4; ++w) if (w < wave) add += wtot[w];
                v += add; acsL[tid] = v; dtL[tid] = dtv; ACS[(size_t)(rowc + tid) * 16 + h] = v;
            }
            __syncthreads();
            const float alast = acsL[255];
#pragma unroll
            for (int i = 0; i < 4; ++i) {
                const int q = tid + 512 * i, l = q >> 3, pc = q & 7;
                const v4u raw = cur.rawx[i];
                const float d = dtL[l];
                LAS unsigned short* dstp = xT + (8 * pc) * 264 + (l ^ (8 * pc));
                dstp[0 * 264] = f2bf1(bflo(raw.x) * d); dstp[1 * 264] = f2bf1(bfhi(raw.x) * d); dstp[2 * 264] = f2bf1(bflo(raw.y) * d); dstp[3 * 264] = f2bf1(bfhi(raw.y) * d);
                dstp[4 * 264] = f2bf1(bflo(raw.z) * d); dstp[5 * 264] = f2bf1(bfhi(raw.z) * d); dstp[6 * 264] = f2bf1(bflo(raw.w) * d); dstp[7 * 264] = f2bf1(bfhi(raw.w) * d);
            }
#pragma unroll
            for (int i = 0; i < 8; ++i) {
                const int q = tid + 512 * i, l = q >> 4, nc = q & 15;
                const v4u raw = cur.rawb[i];
                const float d = __expf(alast - acsL[l]);
                LAS unsigned short* dstp = bT + (8 * nc) * 264 + (l ^ (8 * (nc & 7)));
                dstp[0 * 264] = f2bf1(bflo(raw.x) * d); dstp[1 * 264] = f2bf1(bfhi(raw.x) * d); dstp[2 * 264] = f2bf1(bflo(raw.y) * d); dstp[3 * 264] = f2bf1(bfhi(raw.y) * d);
                dstp[4 * 264] = f2bf1(bflo(raw.z) * d); dstp[5 * 264] = f2bf1(bfhi(raw.z) * d); dstp[6 * 264] = f2bf1(bflo(raw.w) * d); dstp[7 * 264] = f2bf1(bfhi(raw.w) * d);
            }
            __syncthreads();
            if (u + G < 1024) P4_LOAD(u + G, nxt);
#pragma unroll
            for (int i = 0; i < 4; ++i) {
                const int q = tid + 512 * i, p = q >> 5, lc = q & 31;
                *(v4u*)(XDTT + (size_t)u * 16384 + p * 256 + 8 * lc) = *(const LAS v4u*)(xT + p * 264 + 8 * (lc ^ ((p >> 3) & 7)));
            }
            f32x4 acc[4];
#pragma unroll
            for (int pf = 0; pf < 4; ++pf) acc[pf] = (f32x4){0.f, 0.f, 0.f, 0.f};
#pragma unroll
            for (int ks = 0; ks < 8; ++ks) {
                const bf16x8 ba = *(const LAS bf16x8*)(bT + (16 * wave + fr) * 264 + ((32 * ks + 8 * fq) ^ (8 * ((2 * wave + (fr >> 3)) & 7))));
#pragma unroll
                for (int pf = 0; pf < 4; ++pf) { const bf16x8 xb = *(const LAS bf16x8*)(xT + (16 * pf + fr) * 264 + ((32 * ks + 8 * fq) ^ (8 * ((2 * pf + (fr >> 3)) & 7)))); acc[pf] = MFMA16(ba, xb, acc[pf]); }
            }
#pragma unroll
            for (int pf = 0; pf < 4; ++pf) *(f32x4*)(ST + (size_t)u * 8192 + (16 * pf + fr) * 128 + 16 * wave + 4 * fq) = acc[pf];
            __syncthreads();
            cur = nxt;
        }
#undef P4_LOAD
    }
    GRID_SYNC();
    {
        int tid = threadIdx.x; asm volatile("" : "+v"(tid)); const int lane = tid & 63, fr = lane & 15, fq = lane >> 4, gt = bx * 512 + tid; (void)fr; (void)fq; (void)gt;
    for (int vi = gt; vi < 131072; vi += NT) {
        const int e2 = vi * 2, n = e2 & 127, p = (e2 >> 7) & 63, h = (e2 >> 13) & 15, b = e2 >> 17;
        typedef float f32x2s __attribute__((ext_vector_type(2)));
        f32x2s carry = {0.f, 0.f};
        const size_t base = (size_t)(b * 32 * 16 + h) * 8192 + p * 128 + n;
#pragma unroll 1
        for (int c0 = 0; c0 < 32; c0 += 8) {
            f32x2s st[8]; float dc[8];
#pragma unroll
            for (int j = 0; j < 8; ++j) { st[j] = *(const f32x2s*)(ST + base + (size_t)(c0 + j) * 131072); dc[j] = ACS[(size_t)(b * SEQ + (c0 + j) * 256 + 255) * 16 + h]; }
#pragma unroll
            for (int j = 0; j < 8; ++j) { *(unsigned*)(PREV + base + (size_t)(c0 + j) * 131072) = pk2(carry.x, carry.y); carry = carry * __expf(dc[j]) + st[j]; }
        }
    }
    }
    GRID_SYNC();
    {
        int tid = threadIdx.x; asm volatile("" : "+v"(tid)); const int lane = tid & 63, fr = lane & 15, fq = lane >> 4, gt = bx * 512 + tid; (void)fr; (void)fq; (void)gt;
        LAS float* CB = (LAS float*)lds;
        LAS float* acsL = (LAS float*)(lds + 64 * 260 * 4);
        LAS float* ssL = (LAS float*)(lds + 64 * 260 * 4 + 8192);
        for (int uu = bx, rnd = 0; uu < 512; uu += G, ++rnd) {
            const int u = (rnd & 1) ? ((uu & ~3) | (3 - (uu & 3))) : uu;
            const int lb = u & 3, g = (u >> 2) & 1, bc = u >> 3, rowc = bc * 256, l0 = lb * 64, S = l0 + 64;
            for (int sf = wave; sf < S / 16; sf += 8) {
                f32x4 cacc[4];
#pragma unroll
                for (int lf = 0; lf < 4; ++lf) cacc[lf] = (f32x4){0.f, 0.f, 0.f, 0.f};
#pragma unroll
                for (int ks = 0; ks < 4; ++ks) {
                    const bf16x8 ba = *(const bf16x8*)(BMm + (size_t)(rowc + 16 * sf + fr) * 256 + g * 128 + 32 * ks + 8 * fq);
#pragma unroll
                    for (int lf = 0; lf < 4; ++lf) { const bf16x8 cbv = *(const bf16x8*)(CMm + (size_t)(rowc + l0 + 16 * lf + fr) * 256 + g * 128 + 32 * ks + 8 * fq); cacc[lf] = MFMA16(ba, cbv, cacc[lf]); }
                }
#pragma unroll
                for (int lf = 0; lf < 4; ++lf) *(LAS f32x4*)(CB + (16 * lf + fr) * 260 + 16 * sf + 4 * fq) = cacc[lf];
            }
#pragma unroll
            for (int i = 0; i < 4; ++i) { const int q = tid + 512 * i, hh = q >> 8, l = q & 255; acsL[q] = ACS[(size_t)(rowc + l) * 16 + g * 8 + hh]; }
            __syncthreads();
            const int hh = wave, h = g * 8 + hh; const size_t uh = (size_t)(bc * 16 + h);
            f32x4 acc[4][4];
#pragma unroll
            for (int pf = 0; pf < 4; ++pf)
#pragma unroll
                for (int lf = 0; lf < 4; ++lf) acc[pf][lf] = (f32x4){0.f, 0.f, 0.f, 0.f};
#pragma unroll
            for (int ks = 0; ks < 4; ++ks) {
                bf16x8 pa[4];
#pragma unroll
                for (int pf = 0; pf < 4; ++pf) pa[pf] = *(const bf16x8*)(PREV + uh * 8192 + (16 * pf + fr) * 128 + 32 * ks + 8 * fq);
#pragma unroll
                for (int lf = 0; lf < 4; ++lf) { const bf16x8 cbv = *(const bf16x8*)(CMm + (size_t)(rowc + l0 + 16 * lf + fr) * 256 + g * 128 + 32 * ks + 8 * fq);
#pragma unroll
                    for (int pf = 0; pf < 4; ++pf) acc[pf][lf] = MFMA16(pa[pf], cbv, acc[pf][lf]); }
            }
            float al[4];
#pragma unroll
            for (int lf = 0; lf < 4; ++lf) { al[lf] = acsL[hh * 256 + l0 + 16 * lf + fr]; const float e = __expf(al[lf]);
#pragma unroll
                for (int pf = 0; pf < 4; ++pf) acc[pf][lf] = acc[pf][lf] * e; }
            bf16x8 xa[4], xnx[4];
#pragma unroll
            for (int pf = 0; pf < 4; ++pf) xnx[pf] = *(const bf16x8*)(XDTT + uh * 16384 + (16 * pf + fr) * 256 + 8 * fq);
            for (int ks = 0; ks < S / 32; ++ks) {
                const int s0 = 32 * ks + 8 * fq;
                const int sn = 32 * (ks + 1 < S / 32 ? ks + 1 : ks) + 8 * fq;
#pragma unroll
                for (int pf = 0; pf < 4; ++pf) { xa[pf] = xnx[pf]; xnx[pf] = *(const bf16x8*)(XDTT + uh * 16384 + (16 * pf + fr) * 256 + sn); }
                const f32x4 as0 = *(const LAS f32x4*)(acsL + hh * 256 + s0), as1 = *(const LAS f32x4*)(acsL + hh * 256 + s0 + 4);
#pragma unroll
                for (int lf = 0; lf < 4; ++lf) {
                    if (32 * ks > l0 + 16 * lf + 15) continue;
                    const int l = l0 + 16 * lf + fr;
                    const f32x4 c0 = *(const LAS f32x4*)(CB + (16 * lf + fr) * 260 + s0), c1 = *(const LAS f32x4*)(CB + (16 * lf + fr) * 260 + s0 + 4);
                    const float a_l = al[lf];
                    typedef float f2_ __attribute__((ext_vector_type(2)));
                    const f2_ al2 = {a_l, a_l};
                    f2_ t0 = (al2 - (f2_){as0.x, as0.y}) * 1.44269504f, t1 = (al2 - (f2_){as0.z, as0.w}) * 1.44269504f, t2 = (al2 - (f2_){as1.x, as1.y}) * 1.44269504f, t3 = (al2 - (f2_){as1.z, as1.w}) * 1.44269504f;
                    f2_ e0, e1, e2, e3;
                    e0.x = __builtin_amdgcn_exp2f(t0.x); e0.y = __builtin_amdgcn_exp2f(t0.y); e1.x = __builtin_amdgcn_exp2f(t1.x); e1.y = __builtin_amdgcn_exp2f(t1.y);
                    e2.x = __builtin_amdgcn_exp2f(t2.x); e2.y = __builtin_amdgcn_exp2f(t2.y); e3.x = __builtin_amdgcn_exp2f(t3.x); e3.y = __builtin_amdgcn_exp2f(t3.y);
                    e0 = e0 * (f2_){c0.x, c0.y}; e1 = e1 * (f2_){c0.z, c0.w}; e2 = e2 * (f2_){c1.x, c1.y}; e3 = e3 * (f2_){c1.z, c1.w};
                    const float m0 = (s0 + 0 <= l) ? e0.x : 0.f, m1 = (s0 + 1 <= l) ? e0.y : 0.f, m2 = (s0 + 2 <= l) ? e1.x : 0.f, m3 = (s0 + 3 <= l) ? e1.y : 0.f;
                    const float m4 = (s0 + 4 <= l) ? e2.x : 0.f, m5 = (s0 + 5 <= l) ? e2.y : 0.f, m6 = (s0 + 6 <= l) ? e3.x : 0.f, m7 = (s0 + 7 <= l) ? e3.y : 0.f;
                    v4u mw; mw.x = pk2(m0, m1); mw.y = pk2(m2, m3); mw.z = pk2(m4, m5); mw.w = pk2(m6, m7);
                    const bf16x8 mb = __builtin_bit_cast(bf16x8, mw);
#pragma unroll
                    for (int pf = 0; pf < 4; ++pf) acc[pf][lf] = MFMA16(xa[pf], mb, acc[pf][lf]);
                }
            }
            const float Dh = a.in[16][h];
            float ssq[4];
#pragma unroll
            for (int lf = 0; lf < 4; ++lf) {
                const size_t row = (size_t)(rowc + l0 + 16 * lf + fr); float s2 = 0.f;
#pragma unroll
                for (int pf = 0; pf < 4; ++pf) {
                    const int chn = h * 64 + 16 * pf + 4 * fq;
                    const v2u xv = *(const v2u*)(XS + row * 1024 + chn), zv = *(const v2u*)(ZB + row * 1024 + chn);
                    f32x4 y = acc[pf][lf];
                    y.x = (y.x + Dh * bflo(xv.x)) * bflo(zv.x); y.y = (y.y + Dh * bfhi(xv.x)) * bfhi(zv.x); y.z = (y.z + Dh * bflo(xv.y)) * bflo(zv.y); y.w = (y.w + Dh * bfhi(xv.y)) * bfhi(zv.y);
                    acc[pf][lf] = y; s2 += (y.x * y.x + y.y * y.y) + (y.z * y.z + y.w * y.w);
                }
                s2 += __shfl_xor(s2, 16); s2 += __shfl_xor(s2, 32); ssq[lf] = s2;
                if (fq == 0) ssL[hh * 64 + 16 * lf + fr] = s2;
            }
            __syncthreads();
#pragma unroll
            for (int lf = 0; lf < 4; ++lf) {
                float tot = 0.f;
#pragma unroll
                for (int w = 0; w < 8; ++w) tot += ssL[w * 64 + 16 * lf + fr];
                const float rs = __frsqrt_rn(tot * (1.0f / 512.0f) + EPS);
                const size_t row = (size_t)(rowc + l0 + 16 * lf + fr);
#pragma unroll
                for (int pf = 0; pf < 4; ++pf) {
                    const int chn = h * 64 + 16 * pf + 4 * fq;
                    const f32x4 gn = *(const f32x4*)(a.in[17] + chn); const f32x4 y = acc[pf][lf];
                    v2u o; o.x = pk2(y.x * rs * gn.x, y.y * rs * gn.y); o.y = pk2(y.z * rs * gn.z, y.w * rs * gn.w);
                    *(v2u*)(YCAT + row * D + 1024 + chn) = o;
                }
            }
            __syncthreads();
        }
    }
    GRID_SYNC();
    { pg8::Gemm g{YCAT, WOUT, M, D, D}; pg8::StaticOrder S; S.init(M, D, G, bx); pg8::EpiBf16P E{HF2, D};
      pg8::gemm_phase<pg8::EpiBf16P, pg8::StaticOrder, true, true>(lds, g, S, E); }
    GRID_SYNC();
    {
        int tid = threadIdx.x; asm volatile("" : "+v"(tid)); const int lane = tid & 63, fr = lane & 15, fq = lane >> 4, gt = bx * 512 + tid; (void)fr; (void)fq; (void)gt;
        row_pass<1, true, true>(gw, NGW, lane, HF2, X1, X2, 1.0f, a.in[7], a.in[19], XN);
    }
    GRID_SYNC();
    { pg8::Gemm g{XN, WGU2, M, NGU, D}; pg8::StaticOrder S; S.init(M, NGU, G, bx); pg8::EpiSwiGLU E{HB, FF};
      pg8::gemm_phase<pg8::EpiSwiGLU, pg8::StaticOrder, true, true>(lds, g, S, E); }
    GRID_SYNC();
    { pg8::Gemm g{HB, WD2, M, D, FF}; pg8::StaticOrder S; S.init(M, D, G, bx); pg8::EpiBf16P E{HF3, D};
      pg8::gemm_phase<pg8::EpiBf16P, pg8::StaticOrder, true, true, true>(lds, g, S, E); }
    GRID_SYNC();
    {
        int tid = threadIdx.x; asm volatile("" : "+v"(tid)); const int lane = tid & 63, fr = lane & 15, fq = lane >> 4, gt = bx * 512 + tid; (void)fr; (void)fq; (void)gt;
        row_pass<2, true, false>(gw, NGW, lane, HF3, X2, out, 0.5f, a.in[20], nullptr, nullptr);
    }
}

extern "C" void kernel_launch(void* const* d_in, const int* in_sizes, int n_in, void* d_out, int out_size, void* d_ws, size_t ws_size, hipStream_t stream) {
    static int grid = 0;
    if (grid == 0) {
        if (n_in != 24 || out_size != M * D || ws_size < WS_END) { fprintf(stderr, "kernel_launch: unexpected shapes (n_in %d out %d ws %zu)\n", n_in, out_size, ws_size); grid = -1; return; }
        int dev = 0, cus = 0, per_cu = 0;
        hipGetDevice(&dev); hipDeviceGetAttribute(&cus, hipDeviceAttributeMultiprocessorCount, dev);
        if (hipFuncSetAttribute((const void*)fwd_mega, hipFuncAttributeMaxDynamicSharedMemorySize, LDS_BYTES) != hipSuccess) { fprintf(stderr, "kernel_launch: hipFuncSetAttribute failed\n"); grid = -1; return; }
        if (hipOccupancyMaxActiveBlocksPerMultiprocessor(&per_cu, (const void*)fwd_mega, 512, LDS_BYTES) != hipSuccess || per_cu < 1) { fprintf(stderr, "kernel_launch: occupancy query gave %d\n", per_cu); per_cu = 1; }
        (void)hipGetLastError();
        grid = cus * 1;
    }
    if (grid < 0) return;
    Args a{};
    for (int i = 0; i < 24; ++i) a.in[i] = (const float*)d_in[i];
    a.out = (float*)d_out; a.ws = (unsigned char*)d_ws;
    if (hipMemsetAsync((char*)d_ws + WS_BAR, 0, 16384, stream) != hipSuccess) { fprintf(stderr, "kernel_launch: memset failed\n"); return; }
    void* args[] = {&a};
    hipError_t e = hipLaunchCooperativeKernel((const void*)fwd_mega, dim3(grid), dim3(512), args, LDS_BYTES, stream);
    if (e != hipSuccess) fprintf(stderr, "cooperative launch failed: %s (grid %d)\n", hipGetErrorString(e), grid);
}
```
